# Optimizing an MI355X kernel written in HIP

```python
import math
import jax, jax.numpy as jnp
from jax import lax
import numpy as np

D_MODEL = 2048
BATCH = 1
SEQ = 16384
DEPTH = 2
DEC_BATCH = 8
DEC_SEQ = 2048
PAST_LEN = 128

MIX_WIDTH = D_MODEL
ROPE_THETA = 500000.0
RET_THETA = 10000.0
Q_BLOCK = 128
RET_CHUNK = 128
NORM_EPS = 1e-5
A_HEADS = 4
A_DK = 64
A_DV = 2 * A_DK
A_ROT = A_DK // 4
B_HEADS = 6
B_Q_RANK = 512
B_KV_RANK = 256
B_NOPE = 128
B_ROPE = 64
B_DV = 128
C_HEADS = 6
C_DK = 64
C_DV = 128
D_FF = 5632
CONV_WIDTH = 3
IN_SPLIT_SIZES = (A_HEADS * 2 * A_DK, A_HEADS * 2 * A_DK, A_HEADS * A_DV,
                  B_Q_RANK, B_KV_RANK, B_ROPE,
                  C_HEADS * C_DK, C_HEADS * C_DK, C_HEADS * C_DV, C_HEADS * C_DV)
IN_COLS = sum(IN_SPLIT_SIZES)

kernel_name = "hymba_diffattn_mla_retention_encoder"


def rms_norm(x, g, eps=NORM_EPS):
    xf = x.astype(jnp.float32)
    y = xf * lax.rsqrt(jnp.mean(xf * xf, axis=-1, keepdims=True) + eps)
    return (y * g.astype(jnp.float32)).astype(x.dtype)


def rope(x, pos, theta, n_rot):
    half = n_rot // 2
    inv = jnp.power(jnp.float32(theta), -jnp.arange(half, dtype=jnp.float32) * 2.0 / n_rot)
    ang = pos[:, None] * inv[None, :]
    shape = (pos.shape[0],) + (1,) * (x.ndim - 3) + (half,)
    cos = jnp.cos(ang).reshape(shape).astype(x.dtype)
    sin = jnp.sin(ang).reshape(shape).astype(x.dtype)
    x1 = x[..., :half]
    x2 = x[..., half:n_rot]
    return jnp.concatenate([x1 * cos - x2 * sin, x2 * cos + x1 * sin, x[..., n_rot:]], axis=-1)


def blocked_attention(q, k, v, scale, lam=None):
    B, S, H, M, Dk = q.shape
    Dv = v.shape[-1]
    nb = S // Q_BLOCK
    qb = q.reshape(B, nb, Q_BLOCK, H, M, Dk).transpose(1, 0, 2, 3, 4, 5)

    def one_block(q_blk):
        s = jnp.einsum('bqhmd,bkhmd->bhmqk', q_blk, k).astype(jnp.float32) * scale
        p = jax.nn.softmax(s, axis=-1)
        w = p[:, :, 0] if lam is None else p[:, :, 0] - lam * p[:, :, 1]
        return jnp.einsum('bhqk,bkhd->bqhd', w.astype(v.dtype), v)

    o = lax.map(one_block, qb)
    return o.transpose(1, 0, 2, 3, 4).reshape(B, S, H, Dv)


def retention_one_direction(q, k, v, log_gamma, strict):
    B, S, H, Dk = q.shape
    Dv = v.shape[-1]
    C = RET_CHUNK
    N = S // C
    qc = q.reshape(B, N, C, H, Dk)
    kc = k.reshape(B, N, C, H, Dk)
    vc = v.reshape(B, N, C, H, Dv)
    idx = jnp.arange(C, dtype=jnp.float32)
    dist = idx[:, None] - idx[None, :]
    mask = dist > 0 if strict else dist >= 0
    dmat = jnp.where(mask[None], jnp.exp(log_gamma[:, None, None] * jnp.where(mask, dist, 0.0)[None]), 0.0)
    s = jnp.einsum('bnihd,bnjhd->bnhij', qc, kc) * dmat[None, None]
    inner = jnp.einsum('bnhij,bnjhe->bnihe', s, vc)
    k_dec = jnp.exp(log_gamma[None, :] * (C - 1.0 - idx)[:, None])
    q_dec = jnp.exp(log_gamma[None, :] * (idx + 1.0)[:, None])
    chunk_decay = jnp.exp(log_gamma * C)
    U = jnp.einsum('bnjhd,bnjhe->nbhde', kc * k_dec[:, :, None], vc)

    def step(R, U_n):
        return R * chunk_decay[None, :, None, None] + U_n, R

    _, R_prev = lax.scan(step, jnp.zeros((B, H, Dk, Dv), jnp.float32), U)
    cross = jnp.einsum('bnihd,nbhde->bnihe', qc * q_dec[:, :, None], R_prev)
    return (inner + cross).reshape(B, S, H, Dv)


def head_group_mixer(h, l, w_in, diff_lambda, diff_norm, mla_q_norm, mla_kv_norm, w_uq, w_ukv,
                     ret_decay_fwd, ret_decay_bwd, ret_norm, w_o):
    B, S, _ = h.shape
    pos = jnp.arange(S, dtype=jnp.float32)
    z = h @ w_in
    cuts = [int(c) for c in np.cumsum(IN_SPLIT_SIZES)[:-1]]
    za_q, za_k, za_v, zb_cq, zb_ckv, zb_kr, zc_q, zc_k, zc_v, zc_g = jnp.split(z, cuts, axis=-1)

    lam_init = 0.8 - 0.6 * math.exp(-0.3 * l)
    lp = diff_lambda.astype(jnp.float32)
    lam = jnp.exp(jnp.sum(lp[0] * lp[1])) - jnp.exp(jnp.sum(lp[2] * lp[3])) + lam_init
    qa = rope(za_q.reshape(B, S, A_HEADS, 2, A_DK), pos, ROPE_THETA, A_ROT)
    ka = rope(za_k.reshape(B, S, A_HEADS, 2, A_DK), pos, ROPE_THETA, A_ROT)
    va = za_v.reshape(B, S, A_HEADS, A_DV)
    oa = blocked_attention(qa, ka, va, A_DK ** -0.5, lam)
    oa = (rms_norm(oa, diff_norm) * (1.0 - lam_init)).reshape(B, S, A_HEADS * A_DV)

    cq = rms_norm(zb_cq, mla_q_norm)
    qb = (cq @ w_uq).reshape(B, S, B_HEADS, B_NOPE + B_ROPE)
    qb = jnp.concatenate([qb[..., :B_NOPE], rope(qb[..., B_NOPE:], pos, ROPE_THETA, B_ROPE)], axis=-1)
    ckv = rms_norm(zb_ckv, mla_kv_norm)
    kv = (ckv @ w_ukv).reshape(B, S, B_HEADS, B_NOPE + B_DV)
    k_rope = rope(zb_kr[:, :, None, :], pos, ROPE_THETA, B_ROPE)
    kb = jnp.concatenate([kv[..., :B_NOPE], jnp.broadcast_to(k_rope, (B, S, B_HEADS, B_ROPE))], axis=-1)
    vb = kv[..., B_NOPE:]
    ob = blocked_attention(qb[:, :, :, None, :], kb[:, :, :, None, :], vb, (B_NOPE + B_ROPE) ** -0.5)
    ob = ob.reshape(B, S, B_HEADS * B_DV)

    qc = rope(zc_q.reshape(B, S, C_HEADS, C_DK), pos, RET_THETA, C_DK).astype(jnp.float32)
    kc = (rope(zc_k.reshape(B, S, C_HEADS, C_DK), pos, RET_THETA, C_DK) * (C_DK ** -0.5)).astype(jnp.float32)
    vc = zc_v.reshape(B, S, C_HEADS, C_DV).astype(jnp.float32)
    lg_f = jax.nn.log_sigmoid(ret_decay_fwd.astype(jnp.float32))
    lg_b = jax.nn.log_sigmoid(ret_decay_bwd.astype(jnp.float32))
    ret = retention_one_direction(qc, kc, vc, lg_f, False) + \
        retention_one_direction(qc[:, ::-1], kc[:, ::-1], vc[:, ::-1], lg_b, True)[:, ::-1]
    oc = rms_norm(ret, ret_norm).astype(h.dtype).reshape(B, S, C_HEADS * C_DV)
    oc = jax.nn.silu(zc_g) * oc

    return jnp.concatenate([oa, ob, oc], axis=-1) @ w_o


def conv_gated_mlp(h, w_gate, w_up, conv_w, conv_b, w_down):
    S = h.shape[1]
    g = h @ w_gate
    u = h @ w_up
    pad = CONV_WIDTH // 2
    gp = jnp.pad(g, ((0, 0), (pad, pad), (0, 0)))
    gc = conv_b
    for t in range(CONV_WIDTH):
        gc = gc + gp[:, t:t + S] * conv_w[t]
    return (jax.nn.silu(gc) * u) @ w_down


def setup_inputs(seed: int = 0) -> dict:
    key = jax.random.key(seed)
    ks = jax.random.split(key, 24)
    f32 = jnp.float32

    def nrm(k, shape, scale):
        return jax.random.normal(k, shape, f32) * scale

    decay_base = jnp.log(jnp.power(2.0, 5.0 + jnp.arange(C_HEADS, dtype=f32)) - 1.0)
    return {
        "x_prompt": nrm(ks[0], (BATCH, SEQ, D_MODEL), 1.0),
        "x_sample": nrm(ks[1], (DEC_BATCH, DEC_SEQ, D_MODEL), 1.0),
        "norm_mix": 1.0 + nrm(ks[2], (DEPTH, D_MODEL), 0.02),
        "w_in": nrm(ks[3], (DEPTH, D_MODEL, IN_COLS), D_MODEL ** -0.5),
        "diff_lambda": nrm(ks[4], (DEPTH, 4, A_DK), 0.1),
        "diff_norm": 1.0 + nrm(ks[5], (DEPTH, A_DV), 0.02),
        "mla_q_norm": 1.0 + nrm(ks[6], (DEPTH, B_Q_RANK), 0.02),
        "mla_kv_norm": 1.0 + nrm(ks[7], (DEPTH, B_KV_RANK), 0.02),
        "w_uq": nrm(ks[8], (DEPTH, B_Q_RANK, B_HEADS * (B_NOPE + B_ROPE)), B_Q_RANK ** -0.5),
        "w_ukv": nrm(ks[9], (DEPTH, B_KV_RANK, B_HEADS * (B_NOPE + B_DV)), B_KV_RANK ** -0.5),
        "ret_decay_fwd": decay_base[None, :] + nrm(ks[10], (DEPTH, C_HEADS), 0.1),
        "ret_decay_bwd": decay_base[None, :] + nrm(ks[11], (DEPTH, C_HEADS), 0.1),
        "ret_norm": 1.0 + nrm(ks[12], (DEPTH, C_DV), 0.02),
        "w_o": nrm(ks[13], (DEPTH, MIX_WIDTH, D_MODEL), MIX_WIDTH ** -0.5),
        "norm_ffn": 1.0 + nrm(ks[14], (DEPTH, D_MODEL), 0.02),
        "w_gate": nrm(ks[15], (DEPTH, D_MODEL, D_FF), D_MODEL ** -0.5),
        "w_up": nrm(ks[16], (DEPTH, D_MODEL, D_FF), D_MODEL ** -0.5),
        "conv_w": nrm(ks[17], (DEPTH, CONV_WIDTH, D_FF), CONV_WIDTH ** -0.5),
        "conv_b": nrm(ks[18], (DEPTH, D_FF), 0.01),
        "w_down": nrm(ks[19], (DEPTH, D_FF, D_MODEL), D_FF ** -0.5),
        "norm_final": 1.0 + nrm(ks[20], (D_MODEL,), 0.02),
    }


def reference(x_prompt, x_sample, norm_mix, w_in, diff_lambda, diff_norm, mla_q_norm, mla_kv_norm,
              w_uq, w_ukv, ret_decay_fwd, ret_decay_bwd, ret_norm, w_o, norm_ffn, w_gate, w_up,
              conv_w, conv_b, w_down, norm_final):
    def trunk(x):
        for l in range(DEPTH):
            h = rms_norm(x, norm_mix[l])
            x = x + head_group_mixer(h, l, w_in[l], diff_lambda[l], diff_norm[l], mla_q_norm[l],
                                     mla_kv_norm[l], w_uq[l], w_ukv[l], ret_decay_fwd[l],
                                     ret_decay_bwd[l], ret_norm[l], w_o[l])
            h = rms_norm(x, norm_ffn[l])
            x = x + conv_gated_mlp(h, w_gate[l], w_up[l], conv_w[l], conv_b[l], w_down[l])
        return rms_norm(x, norm_final)

    y_prompt = trunk(x_prompt)
    y_sample = trunk(x_sample)
    return (y_prompt, y_sample)
```

```cpp
#include <hip/hip_runtime.h>
#include <hip/hip_cooperative_groups.h>
#include <stdint.h>
#include <cstdio>
namespace cg = cooperative_groups;

#define DI __device__ __forceinline__
typedef unsigned short u16;
using bf16x8 = __attribute__((ext_vector_type(8))) short;
using f32x16 = __attribute__((ext_vector_type(16))) float;
typedef __bf16 bf2_t __attribute__((ext_vector_type(2)));
typedef float f2_t __attribute__((ext_vector_type(2)));
typedef unsigned u32x4 __attribute__((ext_vector_type(4)));
typedef unsigned u32x2 __attribute__((ext_vector_type(2)));
#define MFMA32(a, b, c) __builtin_amdgcn_mfma_f32_32x32x16_bf16((a), (b), (c), 0, 0, 0)

#ifndef COOP
#define COOP 0
#endif

constexpr int T = 16384;
constexpr int DM = 2048;
constexpr int INC = 4672;
constexpr int DFF = 5632;
constexpr float EPS = 1e-5f;
constexpr int NTHR = 256;

constexpr size_t SZ_WT_IN = (size_t)INC * DM * 2;
constexpr size_t SZ_WT_UQ = (size_t)1152 * 512 * 2;
constexpr size_t SZ_WT_UKV = (size_t)1536 * 256 * 2;
constexpr size_t SZ_WT_O = (size_t)DM * DM * 2;
constexpr size_t SZ_WT_GU = (size_t)2 * DFF * DM * 2;
constexpr size_t SZ_WT_DN = (size_t)DM * DFF * 2;
constexpr size_t OFF_WT_IN = 0;
constexpr size_t OFF_WT_UQ = OFF_WT_IN + SZ_WT_IN;
constexpr size_t OFF_WT_UKV = OFF_WT_UQ + SZ_WT_UQ;
constexpr size_t OFF_WT_O = OFF_WT_UKV + SZ_WT_UKV;
constexpr size_t OFF_WT_GU = OFF_WT_O + SZ_WT_O;
constexpr size_t OFF_WT_DN = OFF_WT_GU + SZ_WT_GU;
constexpr size_t OFF_ROPEA = OFF_WT_DN + SZ_WT_DN;
constexpr size_t OFF_ROPEB = OFF_ROPEA + (size_t)16384 * 8 * 8;
constexpr size_t OFF_ROPEC = OFF_ROPEB + (size_t)16384 * 32 * 8;
constexpr size_t OFF_SCAL = OFF_ROPEC + (size_t)16384 * 32 * 8;
constexpr size_t OFF_CNT = OFF_SCAL + 4096;
constexpr size_t OFF_ACT = OFF_CNT + 4096;
constexpr size_t OFF_H = OFF_ACT;
constexpr size_t OFF_QA = OFF_H + (size_t)T * DM * 2;
constexpr size_t OFF_KA = OFF_QA + (size_t)T * 512 * 2;
constexpr size_t OFF_VTA = OFF_KA + (size_t)T * 512 * 2;
constexpr size_t OFF_CQ = OFF_VTA + (size_t)T * 512 * 2;
constexpr size_t OFF_QB = OFF_CQ + (size_t)T * 768 * 2;
constexpr size_t OFF_KB = OFF_QB + (size_t)T * 1152 * 2;
constexpr size_t OFF_VTB = OFF_KB + (size_t)T * 1152 * 2;
constexpr size_t OFF_QC = OFF_VTB + (size_t)T * 768 * 2;
constexpr size_t OFF_KC = OFF_QC + (size_t)T * 384 * 2;
constexpr size_t OFF_KTC = OFF_KC + (size_t)T * 384 * 2;
constexpr size_t OFF_VTC = OFF_KTC + (size_t)T * 384 * 2;
constexpr size_t OFF_G = OFF_VTC + (size_t)T * 768 * 2;
constexpr size_t OFF_R = OFF_G + (size_t)T * 768 * 2;
constexpr size_t OFF_O1 = OFF_R + (size_t)128 * 6 * 2 * 8192 * 2;
constexpr size_t OFF_MIXEND = OFF_O1 + (size_t)T * 512 * 4;
constexpr size_t OFF_GG = OFF_H + (size_t)T * DM * 2;
constexpr size_t OFF_UU = OFF_GG + (size_t)T * DFF * 2;
constexpr size_t OFF_FFNEND = OFF_UU + (size_t)T * DFF * 2;

struct Params {
  const float* x_in[2];
  const float *norm_mix, *w_in, *diff_lambda, *diff_norm, *mla_q_norm, *mla_kv_norm, *w_uq, *w_ukv, *ret_decay_fwd,
      *ret_decay_bwd, *ret_norm, *w_o, *norm_ffn, *w_gate, *w_up, *conv_w, *conv_b, *w_down, *norm_final;
  float* out;
  char* ws;
};

DI unsigned pack2(float a, float b) {
  f2_t v = {a, b};
  bf2_t r = __builtin_convertvector(v, bf2_t);
  return __builtin_bit_cast(unsigned, r);
}
DI u16 f2bf(float a) { return (u16)(pack2(a, 0.f) & 0xffffu); }
DI float bf2f(u16 u) { return __uint_as_float(((unsigned)u) << 16); }
DI float bflo(unsigned u) { return __uint_as_float(u << 16); }
DI float bfhi(unsigned u) { return __uint_as_float(u & 0xffff0000u); }
DI int crow(int i, int h) { return (i & 3) + 8 * (i >> 2) + 4 * h; }
DI float wave_sum(float v) {
#pragma unroll
  for (int o = 32; o > 0; o >>= 1) v += __shfl_xor(v, o);
  return v;
}
DI float fexp2(float x) { return __builtin_amdgcn_exp2f(x); }
DI float silu(float x) { return x / (1.f + __expf(-x)); }
DI bf16x8 pack8(const f32x16& x, int s2) {
  uint4 u;
  u.x = pack2(x[8 * s2 + 0], x[8 * s2 + 1]);
  u.y = pack2(x[8 * s2 + 2], x[8 * s2 + 3]);
  u.z = pack2(x[8 * s2 + 4], x[8 * s2 + 5]);
  u.w = pack2(x[8 * s2 + 6], x[8 * s2 + 7]);
  return __builtin_bit_cast(bf16x8, u);
}
DI bf16x8 scale8(bf16x8 q, float s) {
  uint4 u = __builtin_bit_cast(uint4, q);
  u.x = pack2(bflo(u.x) * s, bfhi(u.x) * s);
  u.y = pack2(bflo(u.y) * s, bfhi(u.y) * s);
  u.z = pack2(bflo(u.z) * s, bfhi(u.z) * s);
  u.w = pack2(bflo(u.w) * s, bfhi(u.w) * s);
  return __builtin_bit_cast(bf16x8, u);
}
DI bf16x8 ld8(const u16* p) { return *(const bf16x8*)p; }
DI void zero16(f32x16& a) {
#pragma unroll
  for (int i = 0; i < 16; ++i) a[i] = 0.f;
}

DI void transpose_tile(const float* __restrict__ src, int N, u16* __restrict__ dst, int ldd, int kt, int nt, float* lds) {
  const int tid = threadIdx.x;
  const int k0 = kt * 64, n0 = nt * 64;
  __syncthreads();
#pragma unroll
  for (int i = 0; i < 16; ++i) {
    int k = i * 4 + (tid >> 6), n = tid & 63;
    lds[k * 65 + n] = src[(size_t)(k0 + k) * N + n0 + n];
  }
  __syncthreads();
#pragma unroll
  for (int j = 0; j < 2; ++j) {
    int n = (tid >> 3) + 32 * j, kc = (tid & 7) * 8;
    uint4 u;
    u.x = pack2(lds[(kc + 0) * 65 + n], lds[(kc + 1) * 65 + n]);
    u.y = pack2(lds[(kc + 2) * 65 + n], lds[(kc + 3) * 65 + n]);
    u.z = pack2(lds[(kc + 4) * 65 + n], lds[(kc + 5) * 65 + n]);
    u.w = pack2(lds[(kc + 6) * 65 + n], lds[(kc + 7) * 65 + n]);
    *(uint4*)(dst + (size_t)(n0 + n) * ldd + k0 + kc) = u;
  }
}

DI void phase_prep(const Params& P, int l, char* smem) {
  float* lds = (float*)smem;
  char* ws = P.ws;
  const int n_in = 32 * 73, n_uq = 8 * 18, n_ukv = 4 * 24, n_o = 32 * 32, n_g = 32 * 88, n_d = 88 * 32;
  const int total = n_in + n_uq + n_ukv + n_o + 2 * n_g + n_d;
  for (int t = blockIdx.x; t < total; t += gridDim.x) {
    int i = t;
    if (i < n_in) { transpose_tile(P.w_in + (size_t)l * DM * INC, INC, (u16*)(ws + OFF_WT_IN), DM, i / 73, i % 73, lds); continue; }
    i -= n_in;
    if (i < n_uq) { transpose_tile(P.w_uq + (size_t)l * 512 * 1152, 1152, (u16*)(ws + OFF_WT_UQ), 512, i / 18, i % 18, lds); continue; }
    i -= n_uq;
    if (i < n_ukv) { transpose_tile(P.w_ukv + (size_t)l * 256 * 1536, 1536, (u16*)(ws + OFF_WT_UKV), 256, i / 24, i % 24, lds); continue; }
    i -= n_ukv;
    if (i < n_o) { transpose_tile(P.w_o + (size_t)l * DM * DM, DM, (u16*)(ws + OFF_WT_O), DM, i / 32, i % 32, lds); continue; }
    i -= n_o;
    if (i < n_g) { transpose_tile(P.w_gate + (size_t)l * DM * DFF, DFF, (u16*)(ws + OFF_WT_GU), DM, i / 88, i % 88, lds); continue; }
    i -= n_g;
    if (i < n_g) { transpose_tile(P.w_up + (size_t)l * DM * DFF, DFF, (u16*)(ws + OFF_WT_GU) + (size_t)DFF * DM, DM, i / 88, i % 88, lds); continue; }
    i -= n_g;
    transpose_tile(P.w_down + (size_t)l * DFF * DM, DM, (u16*)(ws + OFF_WT_DN), DFF, i / 32, i % 32, lds);
  }
  if (l == 0) {
    float2* ra = (float2*)(ws + OFF_ROPEA);
    float2* rb = (float2*)(ws + OFF_ROPEB);
    float2* rc = (float2*)(ws + OFF_ROPEC);
    const int n = 16384 * 72;
    for (int idx = blockIdx.x * NTHR + threadIdx.x; idx < n; idx += gridDim.x * NTHR) {
      int pos = idx / 72, f = idx % 72;
      double ex, th;
      float2* dst;
      if (f < 8) { ex = -(double)f / 8.0; th = 500000.0; dst = ra + pos * 8 + f; }
      else if (f < 40) { ex = -(double)(f - 8) / 32.0; th = 500000.0; dst = rb + pos * 32 + (f - 8); }
      else { ex = -(double)(f - 40) / 32.0; th = 10000.0; dst = rc + pos * 32 + (f - 40); }
      float inv = (float)exp2(ex * log2(th));
      float ang = (float)pos * inv;
      double rev = (double)ang * 0.15915494309189535;
      rev -= rint(rev);
      float a = (float)(rev * 6.283185307179586);
      *dst = make_float2(cosf(a), sinf(a));
    }
  }
  if (blockIdx.x == 0) {
    float* scal = (float*)(ws + OFF_SCAL) + l * 32;
    const int tid = threadIdx.x;
    if (tid < 64) {
      const float* lp = P.diff_lambda + (size_t)l * 256;
      float a = lp[tid] * lp[64 + tid];
      float b = lp[128 + tid] * lp[192 + tid];
      a = wave_sum(a);
      b = wave_sum(b);
      if (tid == 0) {
        float lam_init = 0.8f - 0.6f * expf(-0.3f * (float)l);
        scal[0] = expf(a) - expf(b) + lam_init;
        scal[1] = 1.0f - lam_init;
      }
      if (tid < 6) {
        float xf = P.ret_decay_fwd[l * 6 + tid], xb = P.ret_decay_bwd[l * 6 + tid];
        scal[2 + tid] = -log1pf(expf(-xf)) * 1.4426950408889634f;
        scal[8 + tid] = -log1pf(expf(-xb)) * 1.4426950408889634f;
      }
    }
    if (l == 0) {
      int* cnt = (int*)(ws + OFF_CNT);
      for (int i = tid; i < 1024; i += NTHR) cnt[i] = 0;
    }
  }
}

DI void phase_rmsnorm_bf16(const float* __restrict__ x, const float* __restrict__ g, u16* __restrict__ h) {
  const int lane = threadIdx.x & 63, w = threadIdx.x >> 6;
  for (int row = blockIdx.x * 4 + w; row < T; row += gridDim.x * 4) {
    const float4* xr = (const float4*)(x + (size_t)row * DM);
    float4 v[8];
    float ss = 0.f;
#pragma unroll
    for (int i = 0; i < 8; ++i) {
      v[i] = xr[lane + 64 * i];
      ss += v[i].x * v[i].x + v[i].y * v[i].y + v[i].z * v[i].z + v[i].w * v[i].w;
    }
    ss = wave_sum(ss);
    const float rstd = rsqrtf(ss * (1.f / DM) + EPS);
#pragma unroll
    for (int i = 0; i < 8; ++i) {
      float4 g4 = ((const float4*)g)[lane + 64 * i];
      uint2 o;
      o.x = pack2(v[i].x * rstd * g4.x, v[i].y * rstd * g4.y);
      o.y = pack2(v[i].z * rstd * g4.z, v[i].w * rstd * g4.w);
      *(uint2*)(h + (size_t)row * DM + (lane + 64 * i) * 4) = o;
    }
  }
}

DI void phase_final_norm(float* __restrict__ x, const float* __restrict__ g) {
  const int lane = threadIdx.x & 63, w = threadIdx.x >> 6;
  for (int row = blockIdx.x * 4 + w; row < T; row += gridDim.x * 4) {
    float4* xr = (float4*)(x + (size_t)row * DM);
    float4 v[8];
    float ss = 0.f;
#pragma unroll
    for (int i = 0; i < 8; ++i) {
      v[i] = xr[lane + 64 * i];
      ss += v[i].x * v[i].x + v[i].y * v[i].y + v[i].z * v[i].z + v[i].w * v[i].w;
    }
    ss = wave_sum(ss);
    const float rstd = rsqrtf(ss * (1.f / DM) + EPS);
#pragma unroll
    for (int i = 0; i < 8; ++i) {
      float4 g4 = ((const float4*)g)[lane + 64 * i];
      float4 o = make_float4(v[i].x * rstd * g4.x, v[i].y * rstd * g4.y, v[i].z * rstd * g4.z, v[i].w * rstd * g4.w);
      xr[lane + 64 * i] = o;
    }
  }
}

DI void phase_cqnorm(u16* __restrict__ cq, const float* __restrict__ gq, const float* __restrict__ gkv) {
  const int lane = threadIdx.x & 63, w = threadIdx.x >> 6;
  for (int row = blockIdx.x * 4 + w; row < T; row += gridDim.x * 4) {
    u16* p = cq + (size_t)row * 768;
    uint4 a = *(const uint4*)(p + lane * 8);
    uint2 b = *(const uint2*)(p + 512 + lane * 4);
    float qa[8] = {bflo(a.x), bfhi(a.x), bflo(a.y), bfhi(a.y), bflo(a.z), bfhi(a.z), bflo(a.w), bfhi(a.w)};
    float kb[4] = {bflo(b.x), bfhi(b.x), bflo(b.y), bfhi(b.y)};
    float s1 = 0.f, s2 = 0.f;
#pragma unroll
    for (int i = 0; i < 8; ++i) s1 += qa[i] * qa[i];
#pragma unroll
    for (int i = 0; i < 4; ++i) s2 += kb[i] * kb[i];
    s1 = wave_sum(s1);
    s2 = wave_sum(s2);
    const float r1 = rsqrtf(s1 * (1.f / 512.f) + EPS), r2 = rsqrtf(s2 * (1.f / 256.f) + EPS);
    float4 g0 = ((const float4*)gq)[lane * 2], g1 = ((const float4*)gq)[lane * 2 + 1], g2 = ((const float4*)gkv)[lane];
    uint4 oa;
    oa.x = pack2(qa[0] * r1 * g0.x, qa[1] * r1 * g0.y);
    oa.y = pack2(qa[2] * r1 * g0.z, qa[3] * r1 * g0.w);
    oa.z = pack2(qa[4] * r1 * g1.x, qa[5] * r1 * g1.y);
    oa.w = pack2(qa[6] * r1 * g1.z, qa[7] * r1 * g1.w);
    uint2 ob;
    ob.x = pack2(kb[0] * r2 * g2.x, kb[1] * r2 * g2.y);
    ob.y = pack2(kb[2] * r2 * g2.z, kb[3] * r2 * g2.w);
    *(uint4*)(p + lane * 8) = oa;
    *(uint2*)(p + 512 + lane * 4) = ob;
  }
}

DI void store_T(u16* __restrict__ base, int col, int rb, int h, const f32x16& v) {
#pragma unroll
  for (int g = 0; g < 4; ++g) {
    uint2 pk;
    pk.x = pack2(v[4 * g], v[4 * g + 1]);
    pk.y = pack2(v[4 * g + 2], v[4 * g + 3]);
    *(uint2*)(base + (size_t)col * T + rb + 8 * g + 4 * h) = pk;
  }
}

struct EpiZ {
  u16 *QA, *KA, *VTA, *CQ, *KB, *QC, *KC, *KTC, *VTC, *G;
  const float2 *ropeA, *ropeB, *ropeC;
  int posmask;
  DI void operator()(int rb, int c64, const f32x16& v0, const f32x16& v1) const {
    if (c64 >= INC) return;
    const int lane = threadIdx.x & 63, r = lane & 31, h = lane >> 5;
    if (c64 < 1024) {
      u16* dst = (c64 < 512) ? QA : KA;
      const int cc = c64 & 511;
#pragma unroll
      for (int i = 0; i < 16; ++i) {
        const int t = rb + crow(i, h);
        float x = v0[i];
        float ot = __shfl_xor(x, 8);
        if (r < 16) {
          float2 cs = ropeA[(t & posmask) * 8 + (r & 7)];
          x = (r < 8) ? (x * cs.x - ot * cs.y) : (x * cs.x + ot * cs.y);
        }
        dst[(size_t)t * 512 + cc + r] = f2bf(x);
        dst[(size_t)t * 512 + cc + 32 + r] = f2bf(v1[i]);
      }
    } else if (c64 < 1536) {
      store_T(VTA, c64 - 1024 + r, rb, h, v0);
      store_T(VTA, c64 - 1024 + 32 + r, rb, h, v1);
    } else if (c64 < 2304) {
      const int cc = c64 - 1536;
#pragma unroll
      for (int i = 0; i < 16; ++i) {
        const int t = rb + crow(i, h);
        CQ[(size_t)t * 768 + cc + r] = f2bf(v0[i]);
        CQ[(size_t)t * 768 + cc + 32 + r] = f2bf(v1[i]);
      }
    } else if (c64 < 2368) {
#pragma unroll
      for (int i = 0; i < 16; ++i) {
        const int t = rb + crow(i, h);
        float2 cs = ropeB[(t & posmask) * 32 + r];
        u16 o0 = f2bf(v0[i] * cs.x - v1[i] * cs.y), o1 = f2bf(v1[i] * cs.x + v0[i] * cs.y);
#pragma unroll
        for (int hh = 0; hh < 6; ++hh) {
          KB[(size_t)t * 1152 + hh * 192 + 128 + r] = o0;
          KB[(size_t)t * 1152 + hh * 192 + 160 + r] = o1;
        }
      }
    } else if (c64 < 2752) {
      const int cc = c64 - 2368;
#pragma unroll
      for (int i = 0; i < 16; ++i) {
        const int t = rb + crow(i, h);
        float2 cs = ropeC[(t & posmask) * 32 + r];
        QC[(size_t)t * 384 + cc + r] = f2bf(v0[i] * cs.x - v1[i] * cs.y);
        QC[(size_t)t * 384 + cc + 32 + r] = f2bf(v1[i] * cs.x + v0[i] * cs.y);
      }
    } else if (c64 < 3136) {
      const int cc = c64 - 2752;
      f32x16 o0, o1;
#pragma unroll
      for (int i = 0; i < 16; ++i) {
        const int t = rb + crow(i, h);
        float2 cs = ropeC[(t & posmask) * 32 + r];
        o0[i] = (v0[i] * cs.x - v1[i] * cs.y) * 0.125f;
        o1[i] = (v1[i] * cs.x + v0[i] * cs.y) * 0.125f;
        KC[(size_t)t * 384 + cc + r] = f2bf(o0[i]);
        KC[(size_t)t * 384 + cc + 32 + r] = f2bf(o1[i]);
      }
      store_T(KTC, cc + r, rb, h, o0);
      store_T(KTC, cc + 32 + r, rb, h, o1);
    } else if (c64 < 3904) {
      store_T(VTC, c64 - 3136 + r, rb, h, v0);
      store_T(VTC, c64 - 3136 + 32 + r, rb, h, v1);
    } else {
      const int cc = c64 - 3904;
#pragma unroll
      for (int i = 0; i < 16; ++i) {
        const int t = rb + crow(i, h);
        G[(size_t)t * 768 + cc + r] = f2bf(silu(v0[i]));
        G[(size_t)t * 768 + cc + 32 + r] = f2bf(silu(v1[i]));
      }
    }
  }
};

struct EpiUQ {
  u16* QB;
  const float2* ropeB;
  int posmask;
  DI void operator()(int rb, int c64, const f32x16& v0, const f32x16& v1) const {
    const int lane = threadIdx.x & 63, r = lane & 31, h = lane >> 5;
    const bool isrope = ((c64 >> 6) % 3) == 2;
#pragma unroll
    for (int i = 0; i < 16; ++i) {
      const int t = rb + crow(i, h);
      float a = v0[i], b = v1[i];
      if (isrope) {
        float2 cs = ropeB[(t & posmask) * 32 + r];
        float na = a * cs.x - b * cs.y, nb = b * cs.x + a * cs.y;
        a = na; b = nb;
      }
      QB[(size_t)t * 1152 + c64 + r] = f2bf(a);
      QB[(size_t)t * 1152 + c64 + 32 + r] = f2bf(b);
    }
  }
};

struct EpiUKV {
  u16 *KB, *VTB;
  DI void operator()(int rb, int c64, const f32x16& v0, const f32x16& v1) const {
    const int lane = threadIdx.x & 63, r = lane & 31, h = lane >> 5;
    const int g = c64 >> 6, head = g >> 2, part = g & 3;
    if (part < 2) {
#pragma unroll
      for (int i = 0; i < 16; ++i) {
        const int t = rb + crow(i, h);
        KB[(size_t)t * 1152 + head * 192 + part * 64 + r] = f2bf(v0[i]);
        KB[(size_t)t * 1152 + head * 192 + part * 64 + 32 + r] = f2bf(v1[i]);
      }
    } else {
      const int e = head * 128 + (part - 2) * 64 + r;
      store_T(VTB, e, rb, h, v0);
      store_T(VTB, e + 32, rb, h, v1);
    }
  }
};

struct EpiRes {
  const float* xin;
  float* out;
  DI void operator()(int rb, int c64, const f32x16& v0, const f32x16& v1) const {
    const int lane = threadIdx.x & 63, r = lane & 31, h = lane >> 5;
#pragma unroll
    for (int i = 0; i < 16; ++i) {
      const size_t o = (size_t)(rb + crow(i, h)) * DM + c64 + r;
      out[o] = xin[o] + v0[i];
      out[o + 32] = xin[o + 32] + v1[i];
    }
  }
};

struct EpiGU {
  u16 *GG, *UU;
  DI void operator()(int rb, int c64, const f32x16& v0, const f32x16& v1) const {
    const int lane = threadIdx.x & 63, r = lane & 31, h = lane >> 5;
    u16* dst = (c64 < DFF) ? GG : UU;
    const int cc = (c64 < DFF) ? c64 : c64 - DFF;
#pragma unroll
    for (int i = 0; i < 16; ++i) {
      const size_t o = (size_t)(rb + crow(i, h)) * DFF + cc + r;
      dst[o] = f2bf(v0[i]);
      dst[o + 32] = f2bf(v1[i]);
    }
  }
};

template <int BM, int BN, class Epi>
DI void gemm_phase(const u16* __restrict__ A, int lda, const u16* __restrict__ Bt, int ldb, int M, int N, int K,
                   char* smem, const Epi& epi, int shift) {
  constexpr int WM = BM / 2, WN = BN / 2, MI = WM / 32, NI = WN / 32;
  constexpr int LDS_S = 40;
  constexpr int A_BYTES = BM * LDS_S * 2, B_BYTES = BN * LDS_S * 2, STAGE = A_BYTES + B_BYTES;
  constexpr int ACH = BM * 4 / NTHR, BCH = BN * 4 / NTHR;
  static_assert(2 * STAGE <= 61440, "lds");
  const int tid = threadIdx.x, lane = tid & 63, wv = tid >> 6, r = lane & 31, h = lane >> 5;
  const int wm = wv >> 1, wn = wv & 1;
  const int mtiles = M / BM, ntiles = (N + BN - 1) / BN, total = mtiles * ntiles;
  const int nk = K / 32;
  const int vb = (blockIdx.x + shift) % gridDim.x;
  for (int tile = vb; tile < total; tile += gridDim.x) {
    const int sup = tile / (32 * ntiles), rem = tile % (32 * ntiles);
    const int nt = rem / 32, mt = sup * 32 + (rem % 32);
    const int m0 = mt * BM, n0 = nt * BN;
    f32x16 acc[MI][NI];
#pragma unroll
    for (int i = 0; i < MI; ++i)
#pragma unroll
      for (int j = 0; j < NI; ++j) zero16(acc[i][j]);
    u32x4 ra[ACH], rbv[BCH];
    const u16* ap[ACH];
    const u16* bp[BCH];
#pragma unroll
    for (int i = 0; i < ACH; ++i) {
      int c = tid + NTHR * i, row = c >> 2, cc = c & 3;
      ap[i] = A + (size_t)(m0 + row) * lda + cc * 8;
    }
#pragma unroll
    for (int i = 0; i < BCH; ++i) {
      int c = tid + NTHR * i, row = c >> 2, cc = c & 3;
      int n = n0 + row;
      n = n < N ? n : N - 1;
      bp[i] = Bt + (size_t)n * ldb + cc * 8;
    }
    auto gload = [&](int kt) {
#pragma unroll
      for (int i = 0; i < ACH; ++i) ra[i] = *(const u32x4*)(ap[i] + kt * 32);
#pragma unroll
      for (int i = 0; i < BCH; ++i) rbv[i] = *(const u32x4*)(bp[i] + kt * 32);
    };
    auto swrite = [&](int s) {
      char* base = smem + s * STAGE;
#pragma unroll
      for (int i = 0; i < ACH; ++i) {
        int c = tid + NTHR * i, row = c >> 2, cc = c & 3;
        *(u32x4*)(base + (row * LDS_S + cc * 8) * 2) = ra[i];
      }
#pragma unroll
      for (int i = 0; i < BCH; ++i) {
        int c = tid + NTHR * i, row = c >> 2, cc = c & 3;
        *(u32x4*)(base + A_BYTES + (row * LDS_S + cc * 8) * 2) = rbv[i];
      }
    };
    gload(0);
    swrite(0);
    __syncthreads();
    for (int kt = 0; kt < nk; ++kt) {
      if (kt + 1 < nk) gload(kt + 1);
      const char* base = smem + (kt & 1) * STAGE;
      const u16* As = (const u16*)base + (wm * WM + r) * LDS_S + h * 8;
      const u16* Bs = (const u16*)(base + A_BYTES) + (wn * WN + r) * LDS_S + h * 8;
#pragma unroll
      for (int ks = 0; ks < 2; ++ks) {
        bf16x8 af[MI], bfr[NI];
#pragma unroll
        for (int i = 0; i < MI; ++i) af[i] = ld8(As + i * 32 * LDS_S + ks * 16);
#pragma unroll
        for (int j = 0; j < NI; ++j) bfr[j] = ld8(Bs + j * 32 * LDS_S + ks * 16);
#pragma unroll
        for (int i = 0; i < MI; ++i)
#pragma unroll
          for (int j = 0; j < NI; ++j) acc[i][j] = MFMA32(af[i], bfr[j], acc[i][j]);
      }
      if (kt + 1 < nk) swrite((kt + 1) & 1);
      __syncthreads();
    }
#pragma unroll
    for (int i = 0; i < MI; ++i)
#pragma unroll
      for (int j = 0; j < NI; j += 2) epi(m0 + wm * WM + i * 32, n0 + wn * WN + j * 32, acc[i][j], acc[i][j + 1]);
  }
}

template <int DK>
DI void attn_pass(const u16* __restrict__ Qp, const u16* __restrict__ Kp, int ldk, const u16* __restrict__ Vt, int ntiles,
                  float c, char* smem, f32x16 (&o)[4], float& l_out) {
  constexpr int KS = DK / 16, LDKK = DK + 8, NKC = DK / 32;
  u16* Ks = (u16*)smem;
  u16* Vs = Ks + 64 * LDKK;
  const int tid = threadIdx.x, lane = tid & 63, r = lane & 31, h = lane >> 5;
  bf16x8 qf[KS];
#pragma unroll
  for (int ks = 0; ks < KS; ++ks) qf[ks] = ld8(Qp + ks * 16 + h * 8);
  const u16* kg = Kp + (size_t)(tid >> 2) * ldk + (tid & 3) * 8;
  const u16* vg = Vt + (size_t)(tid >> 1) * T + (tid & 1) * 32;
  u16* kl = Ks + (tid >> 2) * LDKK + (tid & 3) * 8;
  u16* vl = Vs + (tid >> 1) * 72 + (tid & 1) * 32;
  u32x4 kreg[NKC], vreg[4];
#pragma unroll
  for (int i = 0; i < NKC; ++i) kreg[i] = *(const u32x4*)(kg + i * 32);
#pragma unroll
  for (int i = 0; i < 4; ++i) vreg[i] = *(const u32x4*)(vg + i * 8);
  float m = -1e30f, l = 0.f;
#pragma unroll
  for (int e = 0; e < 4; ++e) zero16(o[e]);
  for (int tile = 0; tile < ntiles; ++tile) {
    __syncthreads();
#pragma unroll
    for (int i = 0; i < NKC; ++i) *(u32x4*)(kl + i * 32) = kreg[i];
#pragma unroll
    for (int i = 0; i < 4; ++i) {
      *(u32x2*)(vl + (i >> 1) * 16 + (i & 1) * 4) = u32x2{vreg[i].x, vreg[i].y};
      *(u32x2*)(vl + (i >> 1) * 16 + (i & 1) * 4 + 8) = u32x2{vreg[i].z, vreg[i].w};
    }
    __syncthreads();
    {
      const int tn = (tile + 1 < ntiles) ? tile + 1 : tile;
      const u16* kg2 = kg + (size_t)tn * 64 * ldk;
      const u16* vg2 = vg + tn * 64;
#pragma unroll
      for (int i = 0; i < NKC; ++i) kreg[i] = *(const u32x4*)(kg2 + i * 32);
#pragma unroll
      for (int i = 0; i < 4; ++i) vreg[i] = *(const u32x4*)(vg2 + i * 8);
    }
    f32x16 s[2];
    zero16(s[0]);
    zero16(s[1]);
#pragma unroll
    for (int ks = 0; ks < KS; ++ks) {
#pragma unroll
      for (int kb = 0; kb < 2; ++kb) {
        bf16x8 a = ld8(Ks + (kb * 32 + r) * LDKK + ks * 16 + h * 8);
        s[kb] = MFMA32(a, qf[ks], s[kb]);
      }
    }
    float mx = -1e30f;
#pragma unroll
    for (int kb = 0; kb < 2; ++kb)
#pragma unroll
      for (int i = 0; i < 16; ++i) mx = fmaxf(mx, s[kb][i]);
    mx = fmaxf(mx, __shfl_xor(mx, 32));
    const float mn = fmaxf(m, mx * c);
    const float alpha = fexp2(m - mn);
    m = mn;
    float ps = 0.f;
#pragma unroll
    for (int kb = 0; kb < 2; ++kb)
#pragma unroll
      for (int i = 0; i < 16; ++i) {
        float p = fexp2(fmaf(s[kb][i], c, -mn));
        s[kb][i] = p;
        ps += p;
      }
    ps += __shfl_xor(ps, 32);
    l = l * alpha + ps;
#pragma unroll
    for (int e = 0; e < 4; ++e)
#pragma unroll
      for (int i = 0; i < 16; ++i) o[e][i] *= alpha;
#pragma unroll
    for (int kb = 0; kb < 2; ++kb)
#pragma unroll
      for (int s2 = 0; s2 < 2; ++s2) {
        bf16x8 pf = pack8(s[kb], s2);
#pragma unroll
        for (int e = 0; e < 4; ++e) {
          bf16x8 a = ld8(Vs + (e * 32 + r) * 72 + (kb * 2 + s2) * 16 + h * 8);
          o[e] = MFMA32(a, pf, o[e]);
        }
      }
  }
  l_out = l;
}

DI void attnA_item(const Params& P, int l, int S, int item, char* smem) {
  char* ws = P.ws;
  const int nqb = S / 128;
  const int qb = item % nqb, head = (item / nqb) % 4, seq = item / (nqb * 4);
  const int tid = threadIdx.x, lane = tid & 63, w = tid >> 6, r = lane & 31, h = lane >> 5;
  const int q0 = seq * S + qb * 128, kv0 = seq * S;
  const u16* QA = (const u16*)(ws + OFF_QA);
  const u16* KA = (const u16*)(ws + OFF_KA);
  const u16* VTA = (const u16*)(ws + OFF_VTA);
  const float* scal = (const float*)(ws + OFF_SCAL) + l * 32;
  const int tok = q0 + w * 32 + r;
  const float c = 0.125f * 1.4426950408889634f;
  float* o1s = (float*)(ws + OFF_O1) + (size_t)tok * 512 + head * 128;
  {
    f32x16 o1[4];
    float l1;
    attn_pass<64>(QA + (size_t)tok * 512 + head * 128, KA + (size_t)kv0 * 512 + head * 128, 512,
                  VTA + (size_t)(head * 128) * T + kv0, S / 64, c, smem, o1, l1);
    const float i1 = 1.f / l1;
#pragma unroll
    for (int e = 0; e < 4; ++e)
#pragma unroll
      for (int g = 0; g < 4; ++g) {
        const int e0 = e * 32 + 8 * g + 4 * h;
        *(float4*)(o1s + e0) = make_float4(o1[e][4 * g] * i1, o1[e][4 * g + 1] * i1, o1[e][4 * g + 2] * i1, o1[e][4 * g + 3] * i1);
      }
  }
  f32x16 o2[4];
  float l2;
  attn_pass<64>(QA + (size_t)tok * 512 + head * 128 + 64, KA + (size_t)kv0 * 512 + head * 128 + 64, 512,
                VTA + (size_t)(head * 128) * T + kv0, S / 64, c, smem, o2, l2);
  const float lam = scal[0], oml = scal[1];
  const float i2 = lam / l2;
  float ss = 0.f;
#pragma unroll
  for (int e = 0; e < 4; ++e)
#pragma unroll
    for (int g = 0; g < 4; ++g) {
      const int e0 = e * 32 + 8 * g + 4 * h;
      float4 a = *(const float4*)(o1s + e0);
      float v0 = a.x - i2 * o2[e][4 * g], v1 = a.y - i2 * o2[e][4 * g + 1], v2 = a.z - i2 * o2[e][4 * g + 2], v3 = a.w - i2 * o2[e][4 * g + 3];
      o2[e][4 * g] = v0; o2[e][4 * g + 1] = v1; o2[e][4 * g + 2] = v2; o2[e][4 * g + 3] = v3;
      ss += v0 * v0 + v1 * v1 + v2 * v2 + v3 * v3;
    }
  ss += __shfl_xor(ss, 32);
  const float rstd = rsqrtf(ss * (1.f / 128.f) + EPS) * oml;
  const float* dn = P.diff_norm + l * 128;
  u16* mix = (u16*)(ws + OFF_H);
#pragma unroll
  for (int e = 0; e < 4; ++e)
#pragma unroll
    for (int g = 0; g < 4; ++g) {
      const int e0 = e * 32 + 8 * g + 4 * h;
      float4 gn = *(const float4*)(dn + e0);
      uint2 pk;
      pk.x = pack2(o2[e][4 * g] * rstd * gn.x, o2[e][4 * g + 1] * rstd * gn.y);
      pk.y = pack2(o2[e][4 * g + 2] * rstd * gn.z, o2[e][4 * g + 3] * rstd * gn.w);
      *(uint2*)(mix + (size_t)tok * DM + head * 128 + e0) = pk;
    }
}

DI void attnB_item(const Params& P, int S, int item, char* smem) {
  char* ws = P.ws;
  const int nqb = S / 128;
  const int qb = item % nqb, head = (item / nqb) % 6, seq = item / (nqb * 6);
  const int tid = threadIdx.x, lane = tid & 63, w = tid >> 6, r = lane & 31, h = lane >> 5;
  const int q0 = seq * S + qb * 128, kv0 = seq * S;
  const u16* QB = (const u16*)(ws + OFF_QB);
  const u16* KB = (const u16*)(ws + OFF_KB);
  const u16* VTB = (const u16*)(ws + OFF_VTB);
  const int tok = q0 + w * 32 + r;
  const float c = 0.07216878364870323f * 1.4426950408889634f;
  f32x16 o[4];
  float lsum;
  attn_pass<192>(QB + (size_t)tok * 1152 + head * 192, KB + (size_t)kv0 * 1152 + head * 192, 1152,
                 VTB + (size_t)(head * 128) * T + kv0, S / 64, c, smem, o, lsum);
  const float il = 1.f / lsum;
  u16* mix = (u16*)(ws + OFF_H);
#pragma unroll
  for (int e = 0; e < 4; ++e)
#pragma unroll
    for (int g = 0; g < 4; ++g) {
      const int e0 = e * 32 + 8 * g + 4 * h;
      uint2 pk;
      pk.x = pack2(o[e][4 * g] * il, o[e][4 * g + 1] * il);
      pk.y = pack2(o[e][4 * g + 2] * il, o[e][4 * g + 3] * il);
      *(uint2*)(mix + (size_t)tok * DM + 512 + head * 128 + e0) = pk;
    }
}

DI void retU_item(const Params& P, int l, int item) {
  char* ws = P.ws;
  const int cidx = item / 6, hd = item % 6;
  const int tid = threadIdx.x, lane = tid & 63, w = tid >> 6, r = lane & 31, h = lane >> 5;
  const float* scal = (const float*)(ws + OFF_SCAL) + l * 32;
  const float lf = scal[2 + hd], lb = scal[8 + hd];
  const u16* VTC = (const u16*)(ws + OFF_VTC);
  const u16* KTC = (const u16*)(ws + OFF_KTC);
  const int t0 = cidx * 128;
  f32x16 af[2], ab[2];
  zero16(af[0]); zero16(af[1]); zero16(ab[0]); zero16(ab[1]);
  const u16* vrow = VTC + (size_t)(hd * 128 + w * 32 + r) * T + t0;
  float gpf[8], gpb[8];
#pragma unroll
  for (int jj = 0; jj < 8; ++jj) { gpf[jj] = fexp2(-lf * (float)jj); gpb[jj] = fexp2(lb * (float)jj); }
#pragma unroll 1
  for (int ks = 0; ks < 8; ++ks) {
    bf16x8 a = ld8(vrow + ks * 16 + h * 8);
    float df[8], db[8];
    const float basef = fexp2(lf * (float)(127 - ks * 16 - h * 8)), baseb = fexp2(lb * (float)(ks * 16 + h * 8));
#pragma unroll
    for (int jj = 0; jj < 8; ++jj) {
      df[jj] = basef * gpf[jj];
      db[jj] = baseb * gpb[jj];
    }
#pragma unroll
    for (int nb = 0; nb < 2; ++nb) {
      uint4 raw = *(const uint4*)(KTC + (size_t)(hd * 64 + nb * 32 + r) * T + t0 + ks * 16 + h * 8);
      float kk[8] = {bflo(raw.x), bfhi(raw.x), bflo(raw.y), bfhi(raw.y), bflo(raw.z), bfhi(raw.z), bflo(raw.w), bfhi(raw.w)};
      uint4 uf, ub;
      uf.x = pack2(kk[0] * df[0], kk[1] * df[1]); uf.y = pack2(kk[2] * df[2], kk[3] * df[3]);
      uf.z = pack2(kk[4] * df[4], kk[5] * df[5]); uf.w = pack2(kk[6] * df[6], kk[7] * df[7]);
      ub.x = pack2(kk[0] * db[0], kk[1] * db[1]); ub.y = pack2(kk[2] * db[2], kk[3] * db[3]);
      ub.z = pack2(kk[4] * db[4], kk[5] * db[5]); ub.w = pack2(kk[6] * db[6], kk[7] * db[7]);
      af[nb] = MFMA32(a, __builtin_bit_cast(bf16x8, uf), af[nb]);
      ab[nb] = MFMA32(a, __builtin_bit_cast(bf16x8, ub), ab[nb]);
    }
  }
  float* U = (float*)(ws + OFF_H) + ((size_t)(cidx * 6 + hd) * 2) * 8192;
#pragma unroll
  for (int nb = 0; nb < 2; ++nb)
#pragma unroll
    for (int i = 0; i < 16; ++i) {
      const int e = w * 32 + crow(i, h), d = nb * 32 + r;
      U[e * 64 + d] = af[nb][i];
      U[8192 + e * 64 + d] = ab[nb][i];
    }
}

DI void phase_ret_scan(const Params& P, int l, int S) {
  char* ws = P.ws;
  const float* scal = (const float*)(ws + OFF_SCAL) + l * 32;
  const float* U = (const float*)(ws + OFF_H);
  u16* R = (u16*)(ws + OFF_R);
  const int nseq = T / S, nc = S / 128;
  const int total = nseq * 6 * 2 * 8192;
  for (int idx = blockIdx.x * NTHR + threadIdx.x; idx < total; idx += gridDim.x * NTHR) {
    const int el = idx & 8191, dir = (idx >> 13) & 1, hd = (idx >> 14) % 6, seq = idx / (8192 * 12);
    const float gC = fexp2((dir ? scal[8 + hd] : scal[2 + hd]) * 128.f);
    float Rv = 0.f;
    for (int cc = 0; cc < nc; ++cc) {
      const int ch = dir ? (nc - 1 - cc) : cc;
      const size_t o = ((size_t)((seq * nc + ch) * 6 + hd) * 2 + dir) * 8192 + el;
      R[o] = f2bf(Rv);
      Rv = Rv * gC + U[o];
    }
  }
}

DI void retOut_item(const Params& P, int l, int item) {
  char* ws = P.ws;
  const int cidx = item / 6, hd = item % 6;
  const int tid = threadIdx.x, lane = tid & 63, w = tid >> 6, r = lane & 31, h = lane >> 5;
  const float* scal = (const float*)(ws + OFF_SCAL) + l * 32;
  const float lf = scal[2 + hd], lb = scal[8 + hd];
  const u16* QC = (const u16*)(ws + OFF_QC);
  const u16* KC = (const u16*)(ws + OFF_KC);
  const u16* VTC = (const u16*)(ws + OFF_VTC);
  const u16* G = (const u16*)(ws + OFF_G);
  const u16* Rf = (const u16*)(ws + OFF_R) + ((size_t)(cidx * 6 + hd) * 2) * 8192;
  const u16* Rb = Rf + 8192;
  const int t0 = cidx * 128, il = w * 32 + r, tok = t0 + il;
  bf16x8 q[4], qf[4], qbk[4];
  const float sf = fexp2(lf * (float)(il + 1)), sb = fexp2(lb * (float)(128 - il));
#pragma unroll
  for (int ks = 0; ks < 4; ++ks) {
    q[ks] = ld8(QC + (size_t)tok * 384 + hd * 64 + ks * 16 + h * 8);
    qf[ks] = scale8(q[ks], sf);
    qbk[ks] = scale8(q[ks], sb);
  }
  f32x16 acc[4];
#pragma unroll
  for (int e = 0; e < 4; ++e) {
    zero16(acc[e]);
#pragma unroll
    for (int ks = 0; ks < 4; ++ks) {
      bf16x8 a = ld8(Rf + (e * 32 + r) * 64 + ks * 16 + h * 8);
      acc[e] = MFMA32(a, qf[ks], acc[e]);
      bf16x8 b = ld8(Rb + (e * 32 + r) * 64 + ks * 16 + h * 8);
      acc[e] = MFMA32(b, qbk[ks], acc[e]);
    }
  }
#pragma unroll 1
  for (int jb = 0; jb < 4; ++jb) {
    f32x16 s;
    zero16(s);
#pragma unroll
    for (int ks = 0; ks < 4; ++ks) {
      bf16x8 a = ld8(KC + (size_t)(t0 + jb * 32 + r) * 384 + hd * 64 + ks * 16 + h * 8);
      s = MFMA32(a, q[ks], s);
    }
#pragma unroll
    for (int i = 0; i < 16; ++i) {
      const int j = jb * 32 + crow(i, h);
      const float d = (float)(il - j);
      const float ex = d >= 0.f ? lf * d : -lb * d;
      s[i] *= fexp2(ex);
    }
#pragma unroll
    for (int s2 = 0; s2 < 2; ++s2) {
      bf16x8 pf = pack8(s, s2);
#pragma unroll
      for (int e = 0; e < 4; ++e) {
        const u16* vp = VTC + (size_t)(hd * 128 + e * 32 + r) * T + t0 + jb * 32 + s2 * 16 + 4 * h;
        uint2 lo = *(const uint2*)vp, hi = *(const uint2*)(vp + 8);
        uint4 u = make_uint4(lo.x, lo.y, hi.x, hi.y);
        acc[e] = MFMA32(__builtin_bit_cast(bf16x8, u), pf, acc[e]);
      }
    }
  }
  float ss = 0.f;
#pragma unroll
  for (int e = 0; e < 4; ++e)
#pragma unroll
    for (int i = 0; i < 16; ++i) ss += acc[e][i] * acc[e][i];
  ss += __shfl_xor(ss, 32);
  const float rstd = rsqrtf(ss * (1.f / 128.f) + EPS);
  const float* rn = P.ret_norm + l * 128;
  u16* mix = (u16*)(ws + OFF_H);
#pragma unroll
  for (int e = 0; e < 4; ++e)
#pragma unroll
    for (int g = 0; g < 4; ++g) {
      const int e0 = e * 32 + 8 * g + 4 * h;
      float4 gn = *(const float4*)(rn + e0);
      uint2 gt = *(const uint2*)(G + (size_t)tok * 768 + hd * 128 + e0);
      uint2 pk;
      pk.x = pack2(acc[e][4 * g] * rstd * gn.x * bflo(gt.x), acc[e][4 * g + 1] * rstd * gn.y * bfhi(gt.x));
      pk.y = pack2(acc[e][4 * g + 2] * rstd * gn.z * bflo(gt.y), acc[e][4 * g + 3] * rstd * gn.w * bfhi(gt.y));
      *(uint2*)(mix + (size_t)tok * DM + 1280 + hd * 128 + e0) = pk;
    }
}

DI void phase_conv(const Params& P, int l, int posmask) {
  char* ws = P.ws;
  const u16* GG = (const u16*)(ws + OFF_GG);
  u16* UU = (u16*)(ws + OFF_UU);
  const float* cw = P.conv_w + (size_t)l * 3 * DFF;
  const float* cb = P.conv_b + (size_t)l * DFF;
  const int total = T * (DFF / 8);
  for (int idx = blockIdx.x * NTHR + threadIdx.x; idx < total; idx += gridDim.x * NTHR) {
    const int t = idx / (DFF / 8), c8 = (idx % (DFF / 8)) * 8;
    const int s = t & posmask;
    uint4 g0 = *(const uint4*)(GG + (size_t)(s > 0 ? t - 1 : t) * DFF + c8);
    const uint4 g1 = *(const uint4*)(GG + (size_t)t * DFF + c8);
    uint4 g2 = *(const uint4*)(GG + (size_t)(s < posmask ? t + 1 : t) * DFF + c8);
    const unsigned k0 = (s > 0) ? 0xffffffffu : 0u, k2 = (s < posmask) ? 0xffffffffu : 0u;
    g0.x &= k0; g0.y &= k0; g0.z &= k0; g0.w &= k0;
    g2.x &= k2; g2.y &= k2; g2.z &= k2; g2.w &= k2;
    const uint4 uu = *(const uint4*)(UU + (size_t)t * DFF + c8);
    uint4 res;
#define CONV2(F) { const int c = c8; \
      float x0 = cb[c + OFS] + cw[c + OFS] * bflo(g0.F) + cw[DFF + c + OFS] * bflo(g1.F) + cw[2 * DFF + c + OFS] * bflo(g2.F); \
      float x1 = cb[c + OFS + 1] + cw[c + OFS + 1] * bfhi(g0.F) + cw[DFF + c + OFS + 1] * bfhi(g1.F) + cw[2 * DFF + c + OFS + 1] * bfhi(g2.F); \
      res.F = pack2(silu(x0) * bflo(uu.F), silu(x1) * bfhi(uu.F)); }
#define OFS 0
    CONV2(x)
#undef OFS
#define OFS 2
    CONV2(y)
#undef OFS
#define OFS 4
    CONV2(z)
#undef OFS
#define OFS 6
    CONV2(w)
#undef OFS
#undef CONV2
    *(uint4*)(UU + (size_t)t * DFF + c8) = res;
  }
}

enum { PH_PREP = 0, PH_NORM1, PH_ZGEMM, PH_CQNORM, PH_QKV, PH_SCAN, PH_MIX, PH_WO, PH_NORM2, PH_GU, PH_CONV, PH_DOWN, PH_FINAL, PH_COUNT };

template <int ph>
DI void run_phase(const Params& P, int l, int rq, char* smem, int* s_item) {
  char* ws = P.ws;
  const int S = rq == 0 ? 16384 : 2048;
  const int posmask = S - 1;
  float* xo = P.out + (size_t)rq * T * DM;
  const float* xcur = (l == 0) ? P.x_in[rq] : xo;
  switch (ph) {
    case PH_PREP: phase_prep(P, l, smem); break;
    case PH_NORM1: phase_rmsnorm_bf16(xcur, P.norm_mix + l * DM, (u16*)(ws + OFF_H)); break;
    case PH_ZGEMM: {
      EpiZ e;
      e.QA = (u16*)(ws + OFF_QA); e.KA = (u16*)(ws + OFF_KA); e.VTA = (u16*)(ws + OFF_VTA); e.CQ = (u16*)(ws + OFF_CQ);
      e.KB = (u16*)(ws + OFF_KB); e.QC = (u16*)(ws + OFF_QC); e.KC = (u16*)(ws + OFF_KC); e.KTC = (u16*)(ws + OFF_KTC);
      e.VTC = (u16*)(ws + OFF_VTC); e.G = (u16*)(ws + OFF_G);
      e.ropeA = (const float2*)(ws + OFF_ROPEA); e.ropeB = (const float2*)(ws + OFF_ROPEB); e.ropeC = (const float2*)(ws + OFF_ROPEC);
      e.posmask = posmask;
      gemm_phase<128, 128>((const u16*)(ws + OFF_H), DM, (const u16*)(ws + OFF_WT_IN), DM, T, INC, DM, smem, e, 0);
    } break;
    case PH_CQNORM: phase_cqnorm((u16*)(ws + OFF_CQ), P.mla_q_norm + l * 512, P.mla_kv_norm + l * 256); break;
    case PH_QKV: {
      EpiUQ e1;
      e1.QB = (u16*)(ws + OFF_QB); e1.ropeB = (const float2*)(ws + OFF_ROPEB); e1.posmask = posmask;
      gemm_phase<128, 128>((const u16*)(ws + OFF_CQ), 768, (const u16*)(ws + OFF_WT_UQ), 512, T, 1152, 512, smem, e1, 0);
      EpiUKV e2;
      e2.KB = (u16*)(ws + OFF_KB); e2.VTB = (u16*)(ws + OFF_VTB);
      const int g = gridDim.x;
      gemm_phase<128, 128>((const u16*)(ws + OFF_CQ) + 512, 768, (const u16*)(ws + OFF_WT_UKV), 256, T, 1536, 256, smem, e2,
                           g - (1152 % g));
      const int sh = g - ((1152 + 1536) % g);
      for (int it = (blockIdx.x + sh) % g; it < 128 * 6; it += g) retU_item(P, l, it);
    } break;
    case PH_SCAN: phase_ret_scan(P, l, S); break;
    case PH_MIX: {
      int* cnt = (int*)(ws + OFF_CNT) + (l * 2 + rq);
      const int nA = (T / 128) * 4, nB = (T / 128) * 6, nR = 128 * 6;
      for (;;) {
        __syncthreads();
        if (threadIdx.x == 0) *s_item = atomicAdd(cnt, 1);
        __syncthreads();
        const int it = *s_item;
        if (it >= nA + nB + nR) break;
        if (it < nB) attnB_item(P, S, it, smem);
        else if (it < nB + nA) attnA_item(P, l, S, it - nB, smem);
        else retOut_item(P, l, it - nB - nA);
      }
    } break;
    case PH_WO: {
      EpiRes e;
      e.xin = xcur; e.out = xo;
      gemm_phase<256, 128>((const u16*)(ws + OFF_H), DM, (const u16*)(ws + OFF_WT_O), DM, T, DM, DM, smem, e, 0);
    } break;
    case PH_NORM2: phase_rmsnorm_bf16(xo, P.norm_ffn + l * DM, (u16*)(ws + OFF_H)); break;
    case PH_GU: {
      EpiGU e;
      e.GG = (u16*)(ws + OFF_GG); e.UU = (u16*)(ws + OFF_UU);
      gemm_phase<256, 128>((const u16*)(ws + OFF_H), DM, (const u16*)(ws + OFF_WT_GU), DM, T, 2 * DFF, DM, smem, e, 0);
    } break;
    case PH_CONV: phase_conv(P, l, posmask); break;
    case PH_DOWN: {
      EpiRes e;
      e.xin = xo; e.out = xo;
      gemm_phase<256, 128>((const u16*)(ws + OFF_UU), DFF, (const u16*)(ws + OFF_WT_DN), DFF, T, DM, DFF, smem, e, 0);
    } break;
    case PH_FINAL: phase_final_norm(xo, P.norm_final); break;
  }
}

#if COOP
__global__ void __launch_bounds__(NTHR, 2) mega_kernel(Params P) {
  __shared__ __attribute__((aligned(16))) char smem[61440];
  __shared__ int s_item;
  cg::grid_group grid = cg::this_grid();
#pragma unroll 1
  for (int l = 0; l < 2; ++l) {
    run_phase<PH_PREP>(P, l, 0, smem, &s_item);
    grid.sync();
#pragma unroll 1
    for (int rq = 0; rq < 2; ++rq) {
      run_phase<PH_NORM1>(P, l, rq, smem, &s_item);  grid.sync();
      run_phase<PH_ZGEMM>(P, l, rq, smem, &s_item);  grid.sync();
      run_phase<PH_CQNORM>(P, l, rq, smem, &s_item); grid.sync();
      run_phase<PH_QKV>(P, l, rq, smem, &s_item);    grid.sync();
      run_phase<PH_SCAN>(P, l, rq, smem, &s_item);   grid.sync();
      run_phase<PH_MIX>(P, l, rq, smem, &s_item);    grid.sync();
      run_phase<PH_WO>(P, l, rq, smem, &s_item);     grid.sync();
      run_phase<PH_NORM2>(P, l, rq, smem, &s_item);  grid.sync();
      run_phase<PH_GU>(P, l, rq, smem, &s_item);     grid.sync();
      run_phase<PH_CONV>(P, l, rq, smem, &s_item);   grid.sync();
      run_phase<PH_DOWN>(P, l, rq, smem, &s_item);   grid.sync();
    }
  }
  run_phase<PH_FINAL>(P, 0, 0, smem, &s_item);
  run_phase<PH_FINAL>(P, 0, 1, smem, &s_item);
}
#else
template <int PH>
__global__ void __launch_bounds__(NTHR, 2) phase_kernel(Params P, int l, int rq) {
  __shared__ __attribute__((aligned(16))) char smem[61440];
  __shared__ int s_item;
  run_phase<PH>(P, l, rq, smem, &s_item);
}
#endif

extern "C" void kernel_launch(void* const* d_in, const int* in_sizes, int n_in, void* d_out, int out_size, void* d_ws,
                              size_t ws_size, hipStream_t stream) {
  Params P{};
  P.x_in[0] = (const float*)d_in[0];
  P.x_in[1] = (const float*)d_in[1];
  P.norm_mix = (const float*)d_in[2];
  P.w_in = (const float*)d_in[3];
  P.diff_lambda = (const float*)d_in[4];
  P.diff_norm = (const float*)d_in[5];
  P.mla_q_norm = (const float*)d_in[6];
  P.mla_kv_norm = (const float*)d_in[7];
  P.w_uq = (const float*)d_in[8];
  P.w_ukv = (const float*)d_in[9];
  P.ret_decay_fwd = (const float*)d_in[10];
  P.ret_decay_bwd = (const float*)d_in[11];
  P.ret_norm = (const float*)d_in[12];
  P.w_o = (const float*)d_in[13];
  P.norm_ffn = (const float*)d_in[14];
  P.w_gate = (const float*)d_in[15];
  P.w_up = (const float*)d_in[16];
  P.conv_w = (const float*)d_in[17];
  P.conv_b = (const float*)d_in[18];
  P.w_down = (const float*)d_in[19];
  P.norm_final = (const float*)d_in[20];
  P.out = (float*)d_out;
  P.ws = (char*)d_ws;
  if (ws_size < OFF_FFNEND || ws_size < OFF_MIXEND) {
    fprintf(stderr, "workspace too small: %zu\n", ws_size);
    return;
  }
#if COOP
  static int grid_blocks = 0;
  if (!grid_blocks) {
    int dev = 0, cus = 0, per_cu = 0;
    hipGetDevice(&dev);
    hipDeviceGetAttribute(&cus, hipDeviceAttributeMultiprocessorCount, dev);
    hipOccupancyMaxActiveBlocksPerMultiprocessor(&per_cu, mega_kernel, NTHR, 0);
    if (per_cu > 2) per_cu = 2;
    if (per_cu < 1) per_cu = 1;
    grid_blocks = cus * per_cu;
  }
  void* args[] = {&P};
  hipError_t e = hipLaunchCooperativeKernel((const void*)mega_kernel, dim3(grid_blocks), dim3(NTHR), args, 0, stream);
  if (e != hipSuccess) fprintf(stderr, "cooperative launch failed: %s (grid %d)\n", hipGetErrorString(e), grid_blocks);
#else
  const int grid = 512;
#define LP(PH, l, rq) phase_kernel<PH><<<grid, NTHR, 0, stream>>>(P, l, rq)
  for (int l = 0; l < 2; ++l) {
    LP(PH_PREP, l, 0);
    for (int rq = 0; rq < 2; ++rq) {
      LP(PH_NORM1, l, rq); LP(PH_ZGEMM, l, rq); LP(PH_CQNORM, l, rq); LP(PH_QKV, l, rq); LP(PH_SCAN, l, rq); LP(PH_MIX, l, rq);
      LP(PH_WO, l, rq); LP(PH_NORM2, l, rq); LP(PH_GU, l, rq); LP(PH_CONV, l, rq); LP(PH_DOWN, l, rq);
    }
  }
  LP(PH_FINAL, 0, 0);
  LP(PH_FINAL, 0, 1);
#endif
}
```

```cpp
#include <hip/hip_runtime.h>
#include <hip/hip_cooperative_groups.h>
#include <stdint.h>
#include <cstdio>
namespace cg = cooperative_groups;

#define DI __device__ __forceinline__
typedef unsigned short u16;
using bf16x8 = __attribute__((ext_vector_type(8))) short;
using f32x16 = __attribute__((ext_vector_type(16))) float;
typedef __bf16 bf2_t __attribute__((ext_vector_type(2)));
typedef float f2_t __attribute__((ext_vector_type(2)));
typedef unsigned u32x4 __attribute__((ext_vector_type(4)));
typedef unsigned u32x2 __attribute__((ext_vector_type(2)));
#define MFMA32(a, b, c) __builtin_amdgcn_mfma_f32_32x32x16_bf16((a), (b), (c), 0, 0, 0)

#ifndef COOP
#define COOP 1
#endif

constexpr int T = 16384;
constexpr int DM = 2048;
constexpr int INC = 4672;
constexpr int DFF = 5632;
constexpr float EPS = 1e-5f;
constexpr int NTHR = 512;
constexpr int NWAVE = NTHR / 64;
constexpr int LDS_MAIN = 131072;
constexpr int DYN_LDS = LDS_MAIN + 64;

constexpr size_t SZ_WT_IN = (size_t)INC * DM * 2;
constexpr size_t SZ_WT_UQ = (size_t)1152 * 512 * 2;
constexpr size_t SZ_WT_UKV = (size_t)1536 * 256 * 2;
constexpr size_t SZ_WT_O = (size_t)DM * DM * 2;
constexpr size_t SZ_WT_GU = (size_t)2 * DFF * DM * 2;
constexpr size_t SZ_WT_DN = (size_t)DM * DFF * 2;
constexpr size_t OFF_WT_IN = 0;
constexpr size_t OFF_WT_UQ = OFF_WT_IN + SZ_WT_IN;
constexpr size_t OFF_WT_UKV = OFF_WT_UQ + SZ_WT_UQ;
constexpr size_t OFF_WT_O = OFF_WT_UKV + SZ_WT_UKV;
constexpr size_t OFF_WT_GU = OFF_WT_O + SZ_WT_O;
constexpr size_t OFF_WT_DN = OFF_WT_GU + SZ_WT_GU;
constexpr size_t OFF_ROPEA = OFF_WT_DN + SZ_WT_DN;
constexpr size_t OFF_ROPEB = OFF_ROPEA + (size_t)16384 * 8 * 8;
constexpr size_t OFF_ROPEC = OFF_ROPEB + (size_t)16384 * 32 * 8;
constexpr size_t OFF_SCAL = OFF_ROPEC + (size_t)16384 * 32 * 8;
constexpr size_t OFF_CNT = OFF_SCAL + 4096;
constexpr size_t OFF_BAR = OFF_CNT + 4096;
constexpr size_t OFF_ACT = OFF_BAR + 16384;
constexpr size_t OFF_H = OFF_ACT;
constexpr size_t OFF_QA = OFF_H + (size_t)T * DM * 2;
constexpr size_t OFF_KA = OFF_QA + (size_t)T * 512 * 2;
constexpr size_t OFF_VTA = OFF_KA + (size_t)T * 512 * 2;
constexpr size_t OFF_CQ = OFF_VTA + (size_t)T * 512 * 2;
constexpr size_t OFF_QB = OFF_CQ + (size_t)T * 768 * 2;
constexpr size_t OFF_KB = OFF_QB + (size_t)T * 1152 * 2;
constexpr size_t OFF_VTB = OFF_KB + (size_t)T * 1152 * 2;
constexpr size_t OFF_QC = OFF_VTB + (size_t)T * 768 * 2;
constexpr size_t OFF_KC = OFF_QC + (size_t)T * 384 * 2;
constexpr size_t OFF_KTC = OFF_KC + (size_t)T * 384 * 2;
constexpr size_t OFF_VTC = OFF_KTC + (size_t)T * 384 * 2;
constexpr size_t OFF_G = OFF_VTC + (size_t)T * 768 * 2;
constexpr size_t OFF_R = OFF_G + (size_t)T * 768 * 2;
constexpr size_t OFF_O1 = OFF_R + (size_t)128 * 6 * 2 * 8192 * 2;
constexpr size_t OFF_MIXEND = OFF_O1 + (size_t)2 * T * 512 * 4;
constexpr size_t OFF_GG = OFF_H + (size_t)T * DM * 2;
constexpr size_t OFF_UU = OFF_GG + (size_t)T * DFF * 2;
constexpr size_t OFF_FFNEND = OFF_UU + (size_t)T * DFF * 2;

struct Params {
  const float* x_in[2];
  const float *norm_mix, *w_in, *diff_lambda, *diff_norm, *mla_q_norm, *mla_kv_norm, *w_uq, *w_ukv, *ret_decay_fwd,
      *ret_decay_bwd, *ret_norm, *w_o, *norm_ffn, *w_gate, *w_up, *conv_w, *conv_b, *w_down, *norm_final;
  float* out;
  char* ws;
};

DI unsigned pack2(float a, float b) {
  f2_t v = {a, b};
  bf2_t r = __builtin_convertvector(v, bf2_t);
  return __builtin_bit_cast(unsigned, r);
}
DI u16 f2bf(float a) { return (u16)(pack2(a, 0.f) & 0xffffu); }
DI float bf2f(u16 u) { return __uint_as_float(((unsigned)u) << 16); }
DI float bflo(unsigned u) { return __uint_as_float(u << 16); }
DI float bfhi(unsigned u) { return __uint_as_float(u & 0xffff0000u); }
DI int otid() { int t = threadIdx.x; asm volatile("" : "+v"(t)); return t; }
DI int obid() { int b = __builtin_amdgcn_readfirstlane((int)blockIdx.x); asm volatile("" : "+s"(b)); return b; }
DI char* opq(char* p) {
  unsigned z = 0;
  asm volatile("" : "+s"(z));
  return p + z;
}
DI int crow(int i, int h) { return (i & 3) + 8 * (i >> 2) + 4 * h; }
DI float wave_sum(float v) {
#pragma unroll
  for (int o = 32; o > 0; o >>= 1) v += __shfl_xor(v, o);
  return v;
}
DI float fexp2(float x) { return __builtin_amdgcn_exp2f(x); }
DI float silu(float x) { return x / (1.f + __expf(-x)); }
DI bf16x8 pack8(const f32x16& x, int s2) {
  uint4 u;
  u.x = pack2(x[8 * s2 + 0], x[8 * s2 + 1]);
  u.y = pack2(x[8 * s2 + 2], x[8 * s2 + 3]);
  u.z = pack2(x[8 * s2 + 4], x[8 * s2 + 5]);
  u.w = pack2(x[8 * s2 + 6], x[8 * s2 + 7]);
  return __builtin_bit_cast(bf16x8, u);
}
DI bf16x8 scale8(bf16x8 q, float s) {
  uint4 u = __builtin_bit_cast(uint4, q);
  u.x = pack2(bflo(u.x) * s, bfhi(u.x) * s);
  u.y = pack2(bflo(u.y) * s, bfhi(u.y) * s);
  u.z = pack2(bflo(u.z) * s, bfhi(u.z) * s);
  u.w = pack2(bflo(u.w) * s, bfhi(u.w) * s);
  return __builtin_bit_cast(bf16x8, u);
}
DI bf16x8 ld8(const u16* p) { return *(const bf16x8*)p; }
DI void zero16(f32x16& a) {
#pragma unroll
  for (int i = 0; i < 16; ++i) a[i] = 0.f;
}

DI void transpose_tile(const float* __restrict__ src, int N, u16* __restrict__ dst, int ldd, int kt, int nt, float* lds) {
  const int tid = otid();
  const int k0 = kt * 64, n0 = nt * 64;
  __syncthreads();
#pragma unroll
  for (int i = 0; i < 8; ++i) {
    int k = i * 8 + (tid >> 6), n = tid & 63;
    lds[k * 65 + n] = src[(size_t)(k0 + k) * N + n0 + n];
  }
  __syncthreads();
  {
    int n = (tid >> 3), kc = (tid & 7) * 8;
    uint4 u;
    u.x = pack2(lds[(kc + 0) * 65 + n], lds[(kc + 1) * 65 + n]);
    u.y = pack2(lds[(kc + 2) * 65 + n], lds[(kc + 3) * 65 + n]);
    u.z = pack2(lds[(kc + 4) * 65 + n], lds[(kc + 5) * 65 + n]);
    u.w = pack2(lds[(kc + 6) * 65 + n], lds[(kc + 7) * 65 + n]);
    *(uint4*)(dst + (size_t)(n0 + n) * ldd + k0 + kc) = u;
  }
}

DI void phase_rope(const Params& P) {
  char* ws = opq(P.ws);
    float2* ra = (float2*)(ws + OFF_ROPEA);
    float2* rb = (float2*)(ws + OFF_ROPEB);
    float2* rc = (float2*)(ws + OFF_ROPEC);
    const int n = 16384 * 72;
    for (int idx = obid() * NTHR + otid(); idx < n; idx += gridDim.x * NTHR) {
      int pos = idx / 72, f = idx % 72;
      double ex, th;
      float2* dst;
      if (f < 8) { ex = -(double)f / 8.0; th = 500000.0; dst = ra + pos * 8 + f; }
      else if (f < 40) { ex = -(double)(f - 8) / 32.0; th = 500000.0; dst = rb + pos * 32 + (f - 8); }
      else { ex = -(double)(f - 40) / 32.0; th = 10000.0; dst = rc + pos * 32 + (f - 40); }
      float inv = (float)exp2(ex * log2(th));
      float ang = (float)pos * inv;
      double rev = (double)ang * 0.15915494309189535;
      rev -= rint(rev);
      float a = (float)(rev * 6.283185307179586);
      *dst = make_float2(cosf(a), sinf(a));
    }
  }

DI void phase_prep(const Params& P, int l, char* smem) {
  float* lds = (float*)smem;
  char* ws = opq(P.ws);
  const int n_in = 32 * 73, n_uq = 8 * 18, n_ukv = 4 * 24, n_o = 32 * 32, n_g = 32 * 88, n_d = 88 * 32;
  const int total = n_in + n_uq + n_ukv + n_o + 2 * n_g + n_d;
  for (int t = obid(); t < total; t += gridDim.x) {
    int i = t;
    if (i < n_in) { transpose_tile(P.w_in + (size_t)l * DM * INC, INC, (u16*)(ws + OFF_WT_IN), DM, i / 73, i % 73, lds); continue; }
    i -= n_in;
    if (i < n_uq) { transpose_tile(P.w_uq + (size_t)l * 512 * 1152, 1152, (u16*)(ws + OFF_WT_UQ), 512, i / 18, i % 18, lds); continue; }
    i -= n_uq;
    if (i < n_ukv) { transpose_tile(P.w_ukv + (size_t)l * 256 * 1536, 1536, (u16*)(ws + OFF_WT_UKV), 256, i / 24, i % 24, lds); continue; }
    i -= n_ukv;
    if (i < n_o) { transpose_tile(P.w_o + (size_t)l * DM * DM, DM, (u16*)(ws + OFF_WT_O), DM, i / 32, i % 32, lds); continue; }
    i -= n_o;
    if (i < n_g) { transpose_tile(P.w_gate + (size_t)l * DM * DFF, DFF, (u16*)(ws + OFF_WT_GU), DM, i / 88, i % 88, lds); continue; }
    i -= n_g;
    if (i < n_g) { transpose_tile(P.w_up + (size_t)l * DM * DFF, DFF, (u16*)(ws + OFF_WT_GU) + (size_t)DFF * DM, DM, i / 88, i % 88, lds); continue; }
    i -= n_g;
    transpose_tile(P.w_down + (size_t)l * DFF * DM, DM, (u16*)(ws + OFF_WT_DN), DFF, i / 32, i % 32, lds);
  }
  if (obid() == 0) {
    float* scal = (float*)(ws + OFF_SCAL) + l * 32;
    const int tid = otid();
    if (tid < 64) {
      const float* lp = P.diff_lambda + (size_t)l * 256;
      float a = lp[tid] * lp[64 + tid];
      float b = lp[128 + tid] * lp[192 + tid];
      a = wave_sum(a);
      b = wave_sum(b);
      if (tid == 0) {
        float lam_init = 0.8f - 0.6f * expf(-0.3f * (float)l);
        scal[0] = expf(a) - expf(b) + lam_init;
        scal[1] = 1.0f - lam_init;
      }
      if (tid < 6) {
        float xf = P.ret_decay_fwd[l * 6 + tid], xb = P.ret_decay_bwd[l * 6 + tid];
        scal[2 + tid] = -log1pf(expf(-xf)) * 1.4426950408889634f;
        scal[8 + tid] = -log1pf(expf(-xb)) * 1.4426950408889634f;
      }
    }
  }
}

DI void phase_rmsnorm_bf16(const float* __restrict__ x, const float* __restrict__ g, u16* __restrict__ h) {
  const int lane = otid() & 63, w = otid() >> 6;
  for (int row = obid() * NWAVE + w; row < T; row += gridDim.x * NWAVE) {
    const float4* xr = (const float4*)(x + (size_t)row * DM);
    float4 v[8];
    float ss = 0.f;
#pragma unroll
    for (int i = 0; i < 8; ++i) {
      v[i] = xr[lane + 64 * i];
      ss += v[i].x * v[i].x + v[i].y * v[i].y + v[i].z * v[i].z + v[i].w * v[i].w;
    }
    ss = wave_sum(ss);
    const float rstd = rsqrtf(ss * (1.f / DM) + EPS);
#pragma unroll
    for (int i = 0; i < 8; ++i) {
      float4 g4 = ((const float4*)g)[lane + 64 * i];
      uint2 o;
      o.x = pack2(v[i].x * rstd * g4.x, v[i].y * rstd * g4.y);
      o.y = pack2(v[i].z * rstd * g4.z, v[i].w * rstd * g4.w);
      *(uint2*)(h + (size_t)row * DM + (lane + 64 * i) * 4) = o;
    }
  }
}

DI void phase_final_norm(float* __restrict__ x, const float* __restrict__ g) {
  const int lane = otid() & 63, w = otid() >> 6;
  for (int row = obid() * NWAVE + w; row < T; row += gridDim.x * NWAVE) {
    float4* xr = (float4*)(x + (size_t)row * DM);
    float4 v[8];
    float ss = 0.f;
#pragma unroll
    for (int i = 0; i < 8; ++i) {
      v[i] = xr[lane + 64 * i];
      ss += v[i].x * v[i].x + v[i].y * v[i].y + v[i].z * v[i].z + v[i].w * v[i].w;
    }
    ss = wave_sum(ss);
    const float rstd = rsqrtf(ss * (1.f / DM) + EPS);
#pragma unroll
    for (int i = 0; i < 8; ++i) {
      float4 g4 = ((const float4*)g)[lane + 64 * i];
      float4 o = make_float4(v[i].x * rstd * g4.x, v[i].y * rstd * g4.y, v[i].z * rstd * g4.z, v[i].w * rstd * g4.w);
      xr[lane + 64 * i] = o;
    }
  }
}

DI void phase_cqnorm(u16* __restrict__ cq, const float* __restrict__ gq, const float* __restrict__ gkv) {
  const int lane = otid() & 63, w = otid() >> 6;
  for (int row = obid() * NWAVE + w; row < T; row += gridDim.x * NWAVE) {
    u16* p = cq + (size_t)row * 768;
    uint4 a = *(const uint4*)(p + lane * 8);
    uint2 b = *(const uint2*)(p + 512 + lane * 4);
    float qa[8] = {bflo(a.x), bfhi(a.x), bflo(a.y), bfhi(a.y), bflo(a.z), bfhi(a.z), bflo(a.w), bfhi(a.w)};
    float kb[4] = {bflo(b.x), bfhi(b.x), bflo(b.y), bfhi(b.y)};
    float s1 = 0.f, s2 = 0.f;
#pragma unroll
    for (int i = 0; i < 8; ++i) s1 += qa[i] * qa[i];
#pragma unroll
    for (int i = 0; i < 4; ++i) s2 += kb[i] * kb[i];
    s1 = wave_sum(s1);
    s2 = wave_sum(s2);
    const float r1 = rsqrtf(s1 * (1.f / 512.f) + EPS), r2 = rsqrtf(s2 * (1.f / 256.f) + EPS);
    float4 g0 = ((const float4*)gq)[lane * 2], g1 = ((const float4*)gq)[lane * 2 + 1], g2 = ((const float4*)gkv)[lane];
    uint4 oa;
    oa.x = pack2(qa[0] * r1 * g0.x, qa[1] * r1 * g0.y);
    oa.y = pack2(qa[2] * r1 * g0.z, qa[3] * r1 * g0.w);
    oa.z = pack2(qa[4] * r1 * g1.x, qa[5] * r1 * g1.y);
    oa.w = pack2(qa[6] * r1 * g1.z, qa[7] * r1 * g1.w);
    uint2 ob;
    ob.x = pack2(kb[0] * r2 * g2.x, kb[1] * r2 * g2.y);
    ob.y = pack2(kb[2] * r2 * g2.z, kb[3] * r2 * g2.w);
    *(uint4*)(p + lane * 8) = oa;
    *(uint2*)(p + 512 + lane * 4) = ob;
  }
}

DI void store_T(u16* __restrict__ base, int col, int rb, int h, const f32x16& v) {
#pragma unroll
  for (int g = 0; g < 4; ++g) {
    uint2 pk;
    pk.x = pack2(v[4 * g], v[4 * g + 1]);
    pk.y = pack2(v[4 * g + 2], v[4 * g + 3]);
    *(uint2*)(base + (size_t)col * T + rb + 8 * g + 4 * h) = pk;
  }
}

struct EpiZ {
  u16 *QA, *KA, *VTA, *CQ, *KB, *QC, *KC, *KTC, *VTC, *G;
  const float2 *ropeA, *ropeB, *ropeC;
  int posmask;
  DI void operator()(int rb, int c64, const f32x16& v0, const f32x16& v1) const {
    if (c64 >= INC) return;
    const int lane = otid() & 63, r = lane & 31, h = lane >> 5;
    if (c64 < 1024) {
      u16* dst = (c64 < 512) ? QA : KA;
      const int cc = c64 & 511;
#pragma unroll
      for (int i = 0; i < 16; ++i) {
        const int t = rb + crow(i, h);
        float x = v0[i];
        float ot = __shfl_xor(x, 8);
        if (r < 16) {
          float2 cs = ropeA[(t & posmask) * 8 + (r & 7)];
          x = (r < 8) ? (x * cs.x - ot * cs.y) : (x * cs.x + ot * cs.y);
        }
        dst[(size_t)t * 512 + cc + r] = f2bf(x);
        dst[(size_t)t * 512 + cc + 32 + r] = f2bf(v1[i]);
      }
    } else if (c64 < 1536) {
      store_T(VTA, c64 - 1024 + r, rb, h, v0);
      store_T(VTA, c64 - 1024 + 32 + r, rb, h, v1);
    } else if (c64 < 2304) {
      const int cc = c64 - 1536;
#pragma unroll
      for (int i = 0; i < 16; ++i) {
        const int t = rb + crow(i, h);
        CQ[(size_t)t * 768 + cc + r] = f2bf(v0[i]);
        CQ[(size_t)t * 768 + cc + 32 + r] = f2bf(v1[i]);
      }
    } else if (c64 < 2368) {
#pragma unroll
      for (int i = 0; i < 16; ++i) {
        const int t = rb + crow(i, h);
        float2 cs = ropeB[(t & posmask) * 32 + r];
        u16 o0 = f2bf(v0[i] * cs.x - v1[i] * cs.y), o1 = f2bf(v1[i] * cs.x + v0[i] * cs.y);
#pragma unroll
        for (int hh = 0; hh < 6; ++hh) {
          KB[(size_t)t * 1152 + hh * 192 + 128 + r] = o0;
          KB[(size_t)t * 1152 + hh * 192 + 160 + r] = o1;
        }
      }
    } else if (c64 < 2752) {
      const int cc = c64 - 2368;
#pragma unroll
      for (int i = 0; i < 16; ++i) {
        const int t = rb + crow(i, h);
        float2 cs = ropeC[(t & posmask) * 32 + r];
        QC[(size_t)t * 384 + cc + r] = f2bf(v0[i] * cs.x - v1[i] * cs.y);
        QC[(size_t)t * 384 + cc + 32 + r] = f2bf(v1[i] * cs.x + v0[i] * cs.y);
      }
    } else if (c64 < 3136) {
      const int cc = c64 - 2752;
      f32x16 o0, o1;
#pragma unroll
      for (int i = 0; i < 16; ++i) {
        const int t = rb + crow(i, h);
        float2 cs = ropeC[(t & posmask) * 32 + r];
        o0[i] = (v0[i] * cs.x - v1[i] * cs.y) * 0.125f;
        o1[i] = (v1[i] * cs.x + v0[i] * cs.y) * 0.125f;
        KC[(size_t)t * 384 + cc + r] = f2bf(o0[i]);
        KC[(size_t)t * 384 + cc + 32 + r] = f2bf(o1[i]);
      }
      store_T(KTC, cc + r, rb, h, o0);
      store_T(KTC, cc + 32 + r, rb, h, o1);
    } else if (c64 < 3904) {
      store_T(VTC, c64 - 3136 + r, rb, h, v0);
      store_T(VTC, c64 - 3136 + 32 + r, rb, h, v1);
    } else {
      const int cc = c64 - 3904;
#pragma unroll
      for (int i = 0; i < 16; ++i) {
        const int t = rb + crow(i, h);
        G[(size_t)t * 768 + cc + r] = f2bf(silu(v0[i]));
        G[(size_t)t * 768 + cc + 32 + r] = f2bf(silu(v1[i]));
      }
    }
  }
};

struct EpiUQ {
  u16* QB;
  const float2* ropeB;
  int posmask;
  DI void operator()(int rb, int c64, const f32x16& v0, const f32x16& v1) const {
    const int lane = otid() & 63, r = lane & 31, h = lane >> 5;
    const bool isrope = ((c64 >> 6) % 3) == 2;
#pragma unroll
    for (int i = 0; i < 16; ++i) {
      const int t = rb + crow(i, h);
      float a = v0[i], b = v1[i];
      if (isrope) {
        float2 cs = ropeB[(t & posmask) * 32 + r];
        float na = a * cs.x - b * cs.y, nb = b * cs.x + a * cs.y;
        a = na; b = nb;
      }
      QB[(size_t)t * 1152 + c64 + r] = f2bf(a);
      QB[(size_t)t * 1152 + c64 + 32 + r] = f2bf(b);
    }
  }
};

struct EpiUKV {
  u16 *KB, *VTB;
  DI void operator()(int rb, int c64, const f32x16& v0, const f32x16& v1) const {
    const int lane = otid() & 63, r = lane & 31, h = lane >> 5;
    const int g = c64 >> 6, head = g >> 2, part = g & 3;
    if (part < 2) {
#pragma unroll
      for (int i = 0; i < 16; ++i) {
        const int t = rb + crow(i, h);
        KB[(size_t)t * 1152 + head * 192 + part * 64 + r] = f2bf(v0[i]);
        KB[(size_t)t * 1152 + head * 192 + part * 64 + 32 + r] = f2bf(v1[i]);
      }
    } else {
      const int e = head * 128 + (part - 2) * 64 + r;
      store_T(VTB, e, rb, h, v0);
      store_T(VTB, e + 32, rb, h, v1);
    }
  }
};

struct EpiRes {
  const float* xin;
  float* out;
  DI void operator()(int rb, int c64, const f32x16& v0, const f32x16& v1) const {
    const int lane = otid() & 63, r = lane & 31, h = lane >> 5;
#pragma unroll
    for (int i = 0; i < 16; ++i) {
      const size_t o = (size_t)(rb + crow(i, h)) * DM + c64 + r;
      out[o] = xin[o] + v0[i];
      out[o + 32] = xin[o + 32] + v1[i];
    }
  }
};

struct EpiGU {
  u16 *GG, *UU;
  DI void operator()(int rb, int c64, const f32x16& v0, const f32x16& v1) const {
    const int lane = otid() & 63, r = lane & 31, h = lane >> 5;
    u16* dst = (c64 < DFF) ? GG : UU;
    const int cc = (c64 < DFF) ? c64 : c64 - DFF;
#pragma unroll
    for (int i = 0; i < 16; ++i) {
      const size_t o = (size_t)(rb + crow(i, h)) * DFF + cc + r;
      dst[o] = f2bf(v0[i]);
      dst[o + 32] = f2bf(v1[i]);
    }
  }
};

template <int BM, int BN, class Epi>
DI void gemm_phase(const u16* __restrict__ A, int lda, const u16* __restrict__ Bt, int ldb, int M, int N, int K,
                   char* smem, const Epi& epi, int shift) {
  constexpr int WM = BM / 2, WN = BN / 4, MI = WM / 32, NI = WN / 32;
  constexpr int A_BYTES = BM * 128, B_BYTES = BN * 128, STAGE = A_BYTES + B_BYTES;
  constexpr int NGA = BM / (8 * NWAVE), NGB = BN / (8 * NWAVE);
  static_assert(2 * STAGE <= 131072, "lds");
  static_assert((NGA % 2) == 0 && (NGB % 2) == 0, "piece parity");
  const int tid = otid(), lane = tid & 63, r = lane & 31, h = lane >> 5;
  const int wv = __builtin_amdgcn_readfirstlane(tid >> 6);
  const int wm = wv >> 2, wn = wv & 3;
  const int mtiles = M / BM, ntiles = (N + BN - 1) / BN, total = mtiles * ntiles;
  const int nk = K / 64;
  const int grid = gridDim.x;
  const int vb = (obid() + shift) % grid;
  const int ntl = (vb < total) ? (total - vb + grid - 1) / grid : 0;
  const int nIter = ntl * nk;
  const int cE = (lane & 7) ^ ((lane >> 4) & 7), cO = (lane & 7) ^ (((lane >> 4) + 4) & 7);
  const unsigned offAE = (unsigned)((lane >> 3) * lda + cE * 8) * 2u, offAO = (unsigned)((lane >> 3) * lda + cO * 8) * 2u;
  const unsigned offBE = (unsigned)((lane >> 3) * ldb + cE * 8) * 2u, offBO = (unsigned)((lane >> 3) * ldb + cO * 8) * 2u;
  const int sw = (r >> 1) & 7;
  unsigned fo[4];
#pragma unroll
  for (int ks = 0; ks < 4; ++ks) fo[ks] = (unsigned)(r * 128 + (((ks * 2 + h) ^ sw) * 16));

  int p_t = 0, p_k = 0, p_it = 0;
  auto issue = [&]() {
    const int tile = vb + p_t * grid;
    const int sup = tile / (32 * ntiles), rem = tile % (32 * ntiles);
    const int nt = rem / 32, mt = sup * 32 + (rem % 32);
    const int m0 = mt * BM, n0 = nt * BN;
    char* st = smem + (p_it & 1) * STAGE;
#pragma unroll
    for (int i = 0; i < NGA; ++i) {
      const int rowb = m0 + (wv * NGA + i) * 8;
      const char* g = (const char*)(A + (size_t)rowb * lda + p_k * 64) + ((i & 1) ? offAO : offAE);
      __builtin_amdgcn_global_load_lds((const unsigned*)g, (__attribute__((address_space(3))) unsigned*)(st + (wv * NGA + i) * 1024), 16, 0, 0);
    }
#pragma unroll
    for (int i = 0; i < NGB; ++i) {
      int rowb = n0 + (wv * NGB + i) * 8;
      rowb = rowb <= N - 8 ? rowb : N - 8;
      const char* g = (const char*)(Bt + (size_t)rowb * ldb + p_k * 64) + ((i & 1) ? offBO : offBE);
      __builtin_amdgcn_global_load_lds((const unsigned*)g, (__attribute__((address_space(3))) unsigned*)(st + A_BYTES + (wv * NGB + i) * 1024), 16, 0, 0);
    }
    ++p_it;
    if (++p_k == nk) { p_k = 0; ++p_t; }
  };

  f32x16 acc[MI][NI];
#pragma unroll
  for (int i = 0; i < MI; ++i)
#pragma unroll
    for (int j = 0; j < NI; ++j) zero16(acc[i][j]);

  asm volatile("s_waitcnt vmcnt(0)" ::: "memory");
  __syncthreads();
  bf16x8 fa[2][MI], fb[2][NI];
#define GEMM_LDFRAG(set_, base_, ks_) { const char* As_ = (base_) + (wm * WM) * 128; const char* Bs_ = (base_) + A_BYTES + (wn * WN) * 128; \
    _Pragma("unroll") for (int j = 0; j < NI; ++j) fb[set_][j] = *(const bf16x8*)(Bs_ + j * 4096 + fo[ks_]); \
    _Pragma("unroll") for (int i = 0; i < MI; ++i) fa[set_][i] = *(const bf16x8*)(As_ + i * 4096 + fo[ks_]); }
#define GEMM_MMA(set_) { __builtin_amdgcn_sched_barrier(0); \
    _Pragma("unroll") for (int i = 0; i < MI; ++i) _Pragma("unroll") for (int j = 0; j < NI; ++j) acc[i][j] = MFMA32(fa[set_][i], fb[set_][j], acc[i][j]); \
    __builtin_amdgcn_sched_barrier(0); }
  if (nIter > 0) issue();
  if (nIter > 1) issue();
  if (nIter > 0) {
    if (nIter > 1) asm volatile("s_waitcnt vmcnt(%0)" ::"n"(NGA + NGB) : "memory");
    else asm volatile("s_waitcnt vmcnt(0)" ::: "memory");
    __builtin_amdgcn_s_barrier();
    GEMM_LDFRAG(0, smem, 0);
  }
  __builtin_amdgcn_s_waitcnt(0xC07F);
  int c_t = 0, c_k = 0;
  for (int it = 0; it < nIter; ++it) {
    const char* base = smem + (it & 1) * STAGE;
    GEMM_LDFRAG(1, base, 1);
    GEMM_MMA(0);
    GEMM_LDFRAG(0, base, 2);
    GEMM_MMA(1);
    GEMM_LDFRAG(1, base, 3);
    GEMM_MMA(0);
    __builtin_amdgcn_s_waitcnt(0xC07F);
    asm volatile("s_waitcnt vmcnt(0)" ::: "memory");
    __builtin_amdgcn_s_barrier();
    if (it + 2 < nIter) issue();
    if (it + 1 < nIter) { GEMM_LDFRAG(0, smem + ((it + 1) & 1) * STAGE, 0); }
    GEMM_MMA(1);
    __builtin_amdgcn_s_waitcnt(0xC07F);
    if (++c_k == nk) {
      c_k = 0;
      const int tile = vb + c_t * grid;
      ++c_t;
      const int sup = tile / (32 * ntiles), rem = tile % (32 * ntiles);
      const int nt = rem / 32, mt = sup * 32 + (rem % 32);
      const int m0 = mt * BM, n0 = nt * BN;
#pragma unroll
      for (int i = 0; i < MI; ++i)
#pragma unroll
        for (int j = 0; j < NI; j += 2) {
          if (n0 + wn * WN + j * 32 < N) epi(m0 + wm * WM + i * 32, n0 + wn * WN + j * 32, acc[i][j], acc[i][j + 1]);
          zero16(acc[i][j]);
          zero16(acc[i][j + 1]);
        }
    }
  }
#undef GEMM_LDFRAG
#undef GEMM_MMA
  __syncthreads();
}

template <int DK, int NB>
DI void attn_ldk(const u16* __restrict__ Ks, int ks0, int pr, int h, bf16x8 (&kf)[2 * NB]) {
  constexpr int LDKK = DK + 8;
#pragma unroll
  for (int j = 0; j < NB; ++j)
#pragma unroll
    for (int kb = 0; kb < 2; ++kb) kf[j * 2 + kb] = ld8(Ks + (kb * 32 + pr) * LDKK + (ks0 + j) * 16 + h * 8);
}
template <int DK, int NB>
DI void attn_mmaqk(const bf16x8 (&kf)[2 * NB], const bf16x8 (&qf)[DK / 16], int ks0, f32x16 (&s)[2]) {
  __builtin_amdgcn_sched_barrier(0);
#pragma unroll
  for (int j = 0; j < NB; ++j)
#pragma unroll
    for (int kb = 0; kb < 2; ++kb) s[kb] = MFMA32(kf[j * 2 + kb], qf[ks0 + j], s[kb]);
  __builtin_amdgcn_sched_barrier(0);
}
template <int DK>
DI void attn_qk_full(const u16* __restrict__ Ks, const bf16x8 (&qf)[DK / 16], int pr, int h, f32x16 (&s)[2]) {
  constexpr int KS = DK / 16, NB = 2, NBATCH = KS / NB;
  bf16x8 kf[2][2 * NB];
  attn_ldk<DK, NB>(Ks, 0, pr, h, kf[0]);
#pragma unroll
  for (int b = 0; b < NBATCH; ++b) {
    if (b + 1 < NBATCH) attn_ldk<DK, NB>(Ks, (b + 1) * NB, pr, h, kf[(b + 1) & 1]);
    attn_mmaqk<DK, NB>(kf[b & 1], qf, b * NB, s);
  }
}
DI float attn_exp(f32x16& s, float c, float m, bf16x8& p0, bf16x8& p1) {
  float ps = 0.f;
#pragma unroll
  for (int i = 0; i < 16; ++i) {
    float p = fexp2(fmaf(s[i], c, -m));
    s[i] = p;
    ps += p;
  }
  p0 = pack8(s, 0);
  p1 = pack8(s, 1);
  return ps;
}
DI void attn_ldv(const u16* __restrict__ Vs, int kb, int r, int h, bf16x8 (&vf)[8]) {
#pragma unroll
  for (int s2 = 0; s2 < 2; ++s2)
#pragma unroll
    for (int e = 0; e < 4; ++e) vf[s2 * 4 + e] = ld8(Vs + (e * 32 + r) * 72 + (kb * 2 + s2) * 16 + h * 8);
}
DI void attn_mmapv(const bf16x8 (&vf)[8], const bf16x8& p0, const bf16x8& p1, f32x16 (&o)[4]) {
  __builtin_amdgcn_sched_barrier(0);
#pragma unroll
  for (int e = 0; e < 4; ++e) o[e] = MFMA32(vf[e], p0, o[e]);
#pragma unroll
  for (int e = 0; e < 4; ++e) o[e] = MFMA32(vf[4 + e], p1, o[e]);
  __builtin_amdgcn_sched_barrier(0);
}

template <int DK>
DI void attn_pass(const u16* __restrict__ Qp, const u16* __restrict__ Kp, int ldk, const u16* __restrict__ Vt, int ntiles,
                  float c, char* smem, f32x16 (&o)[4], float& l_out) {
  constexpr bool PIPE = (DK == 64);
  constexpr int KS = DK / 16, LDKK = DK + 8, NKC = DK / 64;
  constexpr int KSTG = 64 * LDKK, VSTG = 128 * 72;
  static_assert((3 * KSTG + 2 * VSTG) * 2 <= LDS_MAIN, "lds");
  const int tid = otid(), lane = tid & 63, r = lane & 31, h = lane >> 5;
  const int pr = (r & 19) | ((r & 4) << 1) | ((r & 8) >> 1);
  bf16x8 qf[KS];
#pragma unroll
  for (int ks = 0; ks < KS; ++ks) qf[ks] = ld8(Qp + ks * 16 + h * 8);
  u16* Kl = (u16*)smem;
  u16* Vl = Kl + 3 * KSTG;
  const u16* kg = Kp + (size_t)(tid >> 3) * ldk + (tid & 7) * 8;
  const u16* vg = Vt + (size_t)(tid >> 2) * T + (tid & 3) * 16;
  const int klo = (tid >> 3) * LDKK + (tid & 7) * 8;
  const int vlo = (tid >> 2) * 72 + (tid & 3) * 16;
  constexpr int NSET = (DK == 64) ? 2 : 1;
  u32x4 kreg[NSET][NKC], vreg[NSET][2];
#define ATT_GLOADK(set_, tile_) { const int tn_ = (tile_) < ntiles ? (tile_) : ntiles - 1; const u16* kg2_ = kg + (size_t)tn_ * 64 * ldk; \
    _Pragma("unroll") for (int i = 0; i < NKC; ++i) kreg[set_][i] = *(const u32x4*)(kg2_ + i * 64); }
#define ATT_GLOADV(set_, tile_) { const int tn_ = (tile_) < ntiles ? (tile_) : ntiles - 1; const u16* vg2_ = vg + tn_ * 64; \
    _Pragma("unroll") for (int i = 0; i < 2; ++i) vreg[set_][i] = *(const u32x4*)(vg2_ + i * 8); }
#define ATT_WRITEK(set_, st_) { u16* sb_ = Kl + (st_) * KSTG + klo; _Pragma("unroll") for (int i = 0; i < NKC; ++i) *(u32x4*)(sb_ + i * 64) = kreg[set_][i]; }
#define ATT_WRITEV(set_, st_) { u16* sb_ = Vl + (st_) * VSTG + vlo; _Pragma("unroll") for (int i = 0; i < 2; ++i) *(u32x4*)(sb_ + i * 8) = vreg[set_][i]; }
  float m = -1e30f, l = 0.f;
#pragma unroll
  for (int e = 0; e < 4; ++e) zero16(o[e]);
  __syncthreads();
  if constexpr (NSET == 2) {
    ATT_GLOADK(0, 0); ATT_GLOADV(0, 0); ATT_GLOADK(1, 1);
    ATT_WRITEK(0, 0); ATT_WRITEV(0, 0); ATT_WRITEK(1, 1);
    ATT_GLOADK(0, 2); ATT_GLOADK(1, 3); ATT_GLOADV(0, 1); ATT_GLOADV(1, 2);
  } else {
    ATT_GLOADK(0, 0); ATT_GLOADV(0, 0);
    ATT_WRITEK(0, 0); ATT_WRITEV(0, 0);
    ATT_GLOADK(0, 1);
    ATT_WRITEK(0, 1);
    ATT_GLOADK(0, 2); ATT_GLOADV(0, 1);
  }
  __syncthreads();
  f32x16 s[2], sn[2];
  if constexpr (PIPE) {
    zero16(s[0]); zero16(s[1]);
    attn_qk_full<DK>(Kl, qf, pr, h, s);
  }
  int kst0 = 0, kst1 = 1, kst2 = 2;
#define ATT_TILE(SET_, tile_) { \
    ATT_WRITEK((SET_) % NSET, kst2); \
    ATT_WRITEV((SET_) % NSET, ((tile_) + 1) & 1); \
    ATT_GLOADK((SET_) % NSET, (tile_) + 2 + NSET); ATT_GLOADV((SET_) % NSET, (tile_) + 1 + NSET); \
    __builtin_amdgcn_sched_barrier(0); \
    const u16* Vs = Vl + ((tile_) & 1) * VSTG; \
    bf16x8 kfp[8]; \
    if constexpr (PIPE) attn_ldk<DK, 4>(Kl + kst1 * KSTG, 0, pr, h, kfp);     \
    if constexpr (!PIPE) { \
      zero16(s[0]); zero16(s[1]); \
      attn_qk_full<DK>(Kl + kst0 * KSTG, qf, pr, h, s); \
    } \
    bf16x8 vf[8]; \
    if constexpr (!PIPE) attn_ldv(Vs, 0, r, h, vf);                         \
    __builtin_amdgcn_sched_barrier(0); \
    float mx = -1e30f; \
    _Pragma("unroll") for (int kb = 0; kb < 2; ++kb) _Pragma("unroll") for (int i = 0; i < 16; ++i) mx = fmaxf(mx, s[kb][i]); \
    mx = fmaxf(mx, __shfl_xor(mx, 32)); \
    float mn = fmaxf(m, mx * c); \
    const bool need = __builtin_amdgcn_readfirstlane(__ballot(mn - m > 6.0f) != 0ull); \
    if (need) { \
      const float alpha = fexp2(m - mn); \
      m = mn; \
      l *= alpha; \
      _Pragma("unroll") for (int e = 0; e < 4; ++e) _Pragma("unroll") for (int i = 0; i < 16; ++i) o[e][i] *= alpha; \
    } \
    bf16x8 p0, p1; \
    if constexpr (PIPE) { \
      zero16(sn[0]); zero16(sn[1]); \
      attn_mmaqk<DK, 4>(kfp, qf, 0, sn); \
      attn_ldv(Vs, 0, r, h, vf);                                             \
      __builtin_amdgcn_sched_barrier(0); \
    } \
    float ps = attn_exp(s[0], c, m, p0, p1); \
    attn_mmapv(vf, p0, p1, o); \
    attn_ldv(Vs, 1, r, h, vf);                                               \
    __builtin_amdgcn_sched_barrier(0); \
    ps += attn_exp(s[1], c, m, p0, p1); \
    attn_mmapv(vf, p0, p1, o); \
    ps += __shfl_xor(ps, 32); \
    l += ps; \
    __syncthreads(); \
    if constexpr (PIPE) { s[0] = sn[0]; s[1] = sn[1]; } \
    kst0 = kst1; \
    kst1 = kst2; \
    kst2 = (kst1 + 1) % 3; }
  for (int tile = 0; tile < ntiles; tile += 2) {
    ATT_TILE(0, tile)
    ATT_TILE(1, tile + 1)
  }
#undef ATT_TILE
#undef ATT_GLOADK
#undef ATT_GLOADV
#undef ATT_WRITEK
#undef ATT_WRITEV
  l_out = l;
}

DI void attnA_item(const Params& P, int l, int S, int item, char* smem) {
  char* ws = opq(P.ws);
  const int nqb = S / 256;
  const int qb = item % nqb, hm = (item / nqb) % 8, seq = item / (nqb * 8);
  const int head = hm >> 1, map = hm & 1;
  const int tid = otid(), lane = tid & 63, w = tid >> 6, r = lane & 31, h = lane >> 5;
  const int q0 = seq * S + qb * 256, kv0 = seq * S;
  const u16* QA = (const u16*)(ws + OFF_QA);
  const u16* KA = (const u16*)(ws + OFF_KA);
  const u16* VTA = (const u16*)(ws + OFF_VTA);
  const int tok = q0 + w * 32 + r;
  const float c = 0.125f * 1.4426950408889634f;
  float* os = (float*)(ws + OFF_O1) + (size_t)map * T * 512 + (size_t)tok * 512 + head * 128;
  f32x16 o1[4];
  float l1;
  attn_pass<64>(QA + (size_t)tok * 512 + head * 128 + map * 64, KA + (size_t)kv0 * 512 + head * 128 + map * 64, 512,
                VTA + (size_t)(head * 128) * T + kv0, S / 64, c, smem, o1, l1);
  const float i1 = 1.f / l1;
#pragma unroll
  for (int e = 0; e < 4; ++e)
#pragma unroll
    for (int g = 0; g < 4; ++g) {
      const int e0 = e * 32 + 8 * g + 4 * h;
      *(float4*)(os + e0) = make_float4(o1[e][4 * g] * i1, o1[e][4 * g + 1] * i1, o1[e][4 * g + 2] * i1, o1[e][4 * g + 3] * i1);
    }
}

DI void phase_combine(const Params& P, int l) {
  char* ws = opq(P.ws);
  const float* scal = (const float*)(ws + OFF_SCAL) + l * 32;
  const float lam = scal[0], oml = scal[1];
  const float* O1 = (const float*)(ws + OFF_O1);
  const float* O2 = O1 + (size_t)T * 512;
  u16* mix = (u16*)(ws + OFF_H);
  const float* dn = P.diff_norm + l * 128;
  const int lane = otid() & 63, w = otid() >> 6;
  const int col = lane * 8;
  const float4 g0 = *(const float4*)(dn + (col & 127)), g1 = *(const float4*)(dn + (col & 127) + 4);
  for (int tok = obid() * NWAVE + w; tok < T; tok += gridDim.x * NWAVE) {
    const float4 a0 = *(const float4*)(O1 + (size_t)tok * 512 + col), a1 = *(const float4*)(O1 + (size_t)tok * 512 + col + 4);
    const float4 b0 = *(const float4*)(O2 + (size_t)tok * 512 + col), b1 = *(const float4*)(O2 + (size_t)tok * 512 + col + 4);
    float v[8] = {a0.x - lam * b0.x, a0.y - lam * b0.y, a0.z - lam * b0.z, a0.w - lam * b0.w,
                  a1.x - lam * b1.x, a1.y - lam * b1.y, a1.z - lam * b1.z, a1.w - lam * b1.w};
    float ss = 0.f;
#pragma unroll
    for (int k = 0; k < 8; ++k) ss += v[k] * v[k];
    ss += __shfl_xor(ss, 1);
    ss += __shfl_xor(ss, 2);
    ss += __shfl_xor(ss, 4);
    ss += __shfl_xor(ss, 8);
    const float rstd = rsqrtf(ss * (1.f / 128.f) + EPS) * oml;
    uint4 pk;
    pk.x = pack2(v[0] * rstd * g0.x, v[1] * rstd * g0.y);
    pk.y = pack2(v[2] * rstd * g0.z, v[3] * rstd * g0.w);
    pk.z = pack2(v[4] * rstd * g1.x, v[5] * rstd * g1.y);
    pk.w = pack2(v[6] * rstd * g1.z, v[7] * rstd * g1.w);
    *(uint4*)(mix + (size_t)tok * DM + col) = pk;
  }
}

DI void attnB_item(const Params& P, int S, int item, char* smem) {
  char* ws = opq(P.ws);
  const int nqb = S / 256;
  const int qb = item % nqb, head = (item / nqb) % 6, seq = item / (nqb * 6);
  const int tid = otid(), lane = tid & 63, w = tid >> 6, r = lane & 31, h = lane >> 5;
  const int q0 = seq * S + qb * 256, kv0 = seq * S;
  const u16* QB = (const u16*)(ws + OFF_QB);
  const u16* KB = (const u16*)(ws + OFF_KB);
  const u16* VTB = (const u16*)(ws + OFF_VTB);
  const int tok = q0 + w * 32 + r;
  const float c = 0.07216878364870323f * 1.4426950408889634f;
  f32x16 o[4];
  float lsum;
  attn_pass<192>(QB + (size_t)tok * 1152 + head * 192, KB + (size_t)kv0 * 1152 + head * 192, 1152,
                 VTB + (size_t)(head * 128) * T + kv0, S / 64, c, smem, o, lsum);
  const float il = 1.f / lsum;
  u16* mix = (u16*)(ws + OFF_H);
#pragma unroll
  for (int e = 0; e < 4; ++e)
#pragma unroll
    for (int g = 0; g < 4; ++g) {
      const int e0 = e * 32 + 8 * g + 4 * h;
      uint2 pk;
      pk.x = pack2(o[e][4 * g] * il, o[e][4 * g + 1] * il);
      pk.y = pack2(o[e][4 * g + 2] * il, o[e][4 * g + 3] * il);
      *(uint2*)(mix + (size_t)tok * DM + 512 + head * 128 + e0) = pk;
    }
}

DI void retU_item(const Params& P, int l, int item2) {
  char* ws = opq(P.ws);
  const int tid = otid(), lane = tid & 63, w = (tid >> 6) & 3, r = lane & 31, h = lane >> 5;
  const int item = item2 * 2 + (tid >> 8);
  const int cidx = item / 6, hd = item % 6;
  const float* scal = (const float*)(ws + OFF_SCAL) + l * 32;
  const float lf = scal[2 + hd], lb = scal[8 + hd];
  const u16* VTC = (const u16*)(ws + OFF_VTC);
  const u16* KTC = (const u16*)(ws + OFF_KTC);
  const int t0 = cidx * 128;
  f32x16 af[2], ab[2];
  zero16(af[0]); zero16(af[1]); zero16(ab[0]); zero16(ab[1]);
  const u16* vrow = VTC + (size_t)(hd * 128 + w * 32 + r) * T + t0;
  float gpf[8], gpb[8];
#pragma unroll
  for (int jj = 0; jj < 8; ++jj) { gpf[jj] = fexp2(-lf * (float)jj); gpb[jj] = fexp2(lb * (float)jj); }
#pragma unroll 1
  for (int ks = 0; ks < 8; ++ks) {
    bf16x8 a = ld8(vrow + ks * 16 + h * 8);
    float df[8], db[8];
    const float basef = fexp2(lf * (float)(127 - ks * 16 - h * 8)), baseb = fexp2(lb * (float)(ks * 16 + h * 8));
#pragma unroll
    for (int jj = 0; jj < 8; ++jj) {
      df[jj] = basef * gpf[jj];
      db[jj] = baseb * gpb[jj];
    }
#pragma unroll
    for (int nb = 0; nb < 2; ++nb) {
      uint4 raw = *(const uint4*)(KTC + (size_t)(hd * 64 + nb * 32 + r) * T + t0 + ks * 16 + h * 8);
      float kk[8] = {bflo(raw.x), bfhi(raw.x), bflo(raw.y), bfhi(raw.y), bflo(raw.z), bfhi(raw.z), bflo(raw.w), bfhi(raw.w)};
      uint4 uf, ub;
      uf.x = pack2(kk[0] * df[0], kk[1] * df[1]); uf.y = pack2(kk[2] * df[2], kk[3] * df[3]);
      uf.z = pack2(kk[4] * df[4], kk[5] * df[5]); uf.w = pack2(kk[6] * df[6], kk[7] * df[7]);
      ub.x = pack2(kk[0] * db[0], kk[1] * db[1]); ub.y = pack2(kk[2] * db[2], kk[3] * db[3]);
      ub.z = pack2(kk[4] * db[4], kk[5] * db[5]); ub.w = pack2(kk[6] * db[6], kk[7] * db[7]);
      af[nb] = MFMA32(a, __builtin_bit_cast(bf16x8, uf), af[nb]);
      ab[nb] = MFMA32(a, __builtin_bit_cast(bf16x8, ub), ab[nb]);
    }
  }
  float* U = (float*)(ws + OFF_H) + ((size_t)(cidx * 6 + hd) * 2) * 8192;
#pragma unroll
  for (int nb = 0; nb < 2; ++nb)
#pragma unroll
    for (int i = 0; i < 16; ++i) {
      const int e = w * 32 + crow(i, h), d = nb * 32 + r;
      U[e * 64 + d] = af[nb][i];
      U[8192 + e * 64 + d] = ab[nb][i];
    }
}

DI void phase_ret_scan(const Params& P, int l, int S) {
  char* ws = opq(P.ws);
  const float* scal = (const float*)(ws + OFF_SCAL) + l * 32;
  const float* U = (const float*)(ws + OFF_H);
  u16* R = (u16*)(ws + OFF_R);
  const int nseq = T / S, nc = S / 128;
  const int total = nseq * 6 * 2 * 8192;
  for (int idx = obid() * NTHR + otid(); idx < total; idx += gridDim.x * NTHR) {
    const int el = idx & 8191, dir = (idx >> 13) & 1, hd = (idx >> 14) % 6, seq = idx / (8192 * 12);
    const float gC = fexp2((dir ? scal[8 + hd] : scal[2 + hd]) * 128.f);
    float Rv = 0.f;
    for (int cc0 = 0; cc0 < nc; cc0 += 8) {
      float uv[8];
      size_t oo[8];
#pragma unroll
      for (int k = 0; k < 8; ++k) {
        const int cc = cc0 + k;
        const int ch = dir ? (nc - 1 - cc) : cc;
        oo[k] = ((size_t)((seq * nc + ch) * 6 + hd) * 2 + dir) * 8192 + el;
        uv[k] = U[oo[k]];
      }
#pragma unroll
      for (int k = 0; k < 8; ++k) {
        R[oo[k]] = f2bf(Rv);
        Rv = Rv * gC + uv[k];
      }
    }
  }
}

DI void retOut_item(const Params& P, int l, int item2) {
  char* ws = opq(P.ws);
  const int tid = otid(), lane = tid & 63, w = (tid >> 6) & 3, r = lane & 31, h = lane >> 5;
  const int item = item2 * 2 + (tid >> 8);
  const int cidx = item / 6, hd = item % 6;
  const float* scal = (const float*)(ws + OFF_SCAL) + l * 32;
  const float lf = scal[2 + hd], lb = scal[8 + hd];
  const u16* QC = (const u16*)(ws + OFF_QC);
  const u16* KC = (const u16*)(ws + OFF_KC);
  const u16* VTC = (const u16*)(ws + OFF_VTC);
  const u16* G = (const u16*)(ws + OFF_G);
  const u16* Rf = (const u16*)(ws + OFF_R) + ((size_t)(cidx * 6 + hd) * 2) * 8192;
  const u16* Rb = Rf + 8192;
  const int t0 = cidx * 128, il = w * 32 + r, tok = t0 + il;
  bf16x8 q[4], qf[4], qbk[4];
  const float sf = fexp2(lf * (float)(il + 1)), sb = fexp2(lb * (float)(128 - il));
#pragma unroll
  for (int ks = 0; ks < 4; ++ks) {
    q[ks] = ld8(QC + (size_t)tok * 384 + hd * 64 + ks * 16 + h * 8);
    qf[ks] = scale8(q[ks], sf);
    qbk[ks] = scale8(q[ks], sb);
  }
  f32x16 acc[4];
#pragma unroll
  for (int e = 0; e < 4; ++e) {
    zero16(acc[e]);
#pragma unroll
    for (int ks = 0; ks < 4; ++ks) {
      bf16x8 a = ld8(Rf + (e * 32 + r) * 64 + ks * 16 + h * 8);
      acc[e] = MFMA32(a, qf[ks], acc[e]);
      bf16x8 b = ld8(Rb + (e * 32 + r) * 64 + ks * 16 + h * 8);
      acc[e] = MFMA32(b, qbk[ks], acc[e]);
    }
  }
#pragma unroll 1
  for (int jb = 0; jb < 4; ++jb) {
    f32x16 s;
    zero16(s);
#pragma unroll
    for (int ks = 0; ks < 4; ++ks) {
      bf16x8 a = ld8(KC + (size_t)(t0 + jb * 32 + r) * 384 + hd * 64 + ks * 16 + h * 8);
      s = MFMA32(a, q[ks], s);
    }
#pragma unroll
    for (int i = 0; i < 16; ++i) {
      const int j = jb * 32 + crow(i, h);
      const float d = (float)(il - j);
      const float ex = d >= 0.f ? lf * d : -lb * d;
      s[i] *= fexp2(ex);
    }
#pragma unroll
    for (int s2 = 0; s2 < 2; ++s2) {
      bf16x8 pf = pack8(s, s2);
#pragma unroll
      for (int e = 0; e < 4; ++e) {
        const u16* vp = VTC + (size_t)(hd * 128 + e * 32 + r) * T + t0 + jb * 32 + s2 * 16 + 4 * h;
        uint2 lo = *(const uint2*)vp, hi = *(const uint2*)(vp + 8);
        uint4 u = make_uint4(lo.x, lo.y, hi.x, hi.y);
        acc[e] = MFMA32(__builtin_bit_cast(bf16x8, u), pf, acc[e]);
      }
    }
  }
  float ss = 0.f;
#pragma unroll
  for (int e = 0; e < 4; ++e)
#pragma unroll
    for (int i = 0; i < 16; ++i) ss += acc[e][i] * acc[e][i];
  ss += __shfl_xor(ss, 32);
  const float rstd = rsqrtf(ss * (1.f / 128.f) + EPS);
  const float* rn = P.ret_norm + l * 128;
  u16* mix = (u16*)(ws + OFF_H);
#pragma unroll
  for (int e = 0; e < 4; ++e)
#pragma unroll
    for (int g = 0; g < 4; ++g) {
      const int e0 = e * 32 + 8 * g + 4 * h;
      float4 gn = *(const float4*)(rn + e0);
      uint2 gt = *(const uint2*)(G + (size_t)tok * 768 + hd * 128 + e0);
      uint2 pk;
      pk.x = pack2(acc[e][4 * g] * rstd * gn.x * bflo(gt.x), acc[e][4 * g + 1] * rstd * gn.y * bfhi(gt.x));
      pk.y = pack2(acc[e][4 * g + 2] * rstd * gn.z * bflo(gt.y), acc[e][4 * g + 3] * rstd * gn.w * bfhi(gt.y));
      *(uint2*)(mix + (size_t)tok * DM + 1280 + hd * 128 + e0) = pk;
    }
}

DI uint4 conv8(const uint4& g0, const uint4& g1, const uint4& g2, const uint4& uu, const float (&cb8)[8], const float (&w0)[8],
               const float (&w1)[8], const float (&w2)[8]) {
  uint4 res;
#define CONV2(F, O) { \
    float x0 = cb8[O] + w0[O] * bflo(g0.F) + w1[O] * bflo(g1.F) + w2[O] * bflo(g2.F); \
    float x1 = cb8[O + 1] + w0[O + 1] * bfhi(g0.F) + w1[O + 1] * bfhi(g1.F) + w2[O + 1] * bfhi(g2.F); \
    res.F = pack2(silu(x0) * bflo(uu.F), silu(x1) * bfhi(uu.F)); }
  CONV2(x, 0) CONV2(y, 2) CONV2(z, 4) CONV2(w, 6)
#undef CONV2
  return res;
}

DI void phase_conv(const Params& P, int l, int posmask) {
  char* ws = opq(P.ws);
  const u16* __restrict__ GG = (const u16*)(ws + OFF_GG);
  u16* __restrict__ UU = (u16*)(ws + OFF_UU);
  const float* cw = P.conv_w + (size_t)l * 3 * DFF;
  const float* cbp = P.conv_b + (size_t)l * DFF;
  constexpr int NCG = DFF / 8, TB = 32;
  const int total = (T / TB) * NCG;
  for (int task = obid() * NTHR + otid(); task < total; task += gridDim.x * NTHR) {
    const int tb = task / NCG, c8 = (task % NCG) * 8;
    const int t0 = tb * TB;
    float cb8[8], w0[8], w1[8], w2[8];
#pragma unroll
    for (int k = 0; k < 2; ++k) {
      float4 a = *(const float4*)(cbp + c8 + 4 * k), b0 = *(const float4*)(cw + c8 + 4 * k), b1 = *(const float4*)(cw + DFF + c8 + 4 * k),
             b2 = *(const float4*)(cw + 2 * DFF + c8 + 4 * k);
      cb8[4 * k] = a.x; cb8[4 * k + 1] = a.y; cb8[4 * k + 2] = a.z; cb8[4 * k + 3] = a.w;
      w0[4 * k] = b0.x; w0[4 * k + 1] = b0.y; w0[4 * k + 2] = b0.z; w0[4 * k + 3] = b0.w;
      w1[4 * k] = b1.x; w1[4 * k + 1] = b1.y; w1[4 * k + 2] = b1.z; w1[4 * k + 3] = b1.w;
      w2[4 * k] = b2.x; w2[4 * k + 1] = b2.y; w2[4 * k + 2] = b2.z; w2[4 * k + 3] = b2.w;
    }
    const u16* gp = GG + (size_t)t0 * DFF + c8;
    u16* up = UU + (size_t)t0 * DFF + c8;
    const int s0 = t0 & posmask;
    uint4 gm = *(const uint4*)(gp - (s0 > 0 ? DFF : 0));
    {
      const unsigned k0 = (s0 > 0) ? 0xffffffffu : 0u;
      gm.x &= k0; gm.y &= k0; gm.z &= k0; gm.w &= k0;
    }
    uint4 gc = *(const uint4*)gp;
#pragma unroll 1
    for (int j = 0; j < TB; j += 4) {
      uint4 gn[4], uu[4];
#pragma unroll
      for (int k = 0; k < 4; ++k) {
        const bool last = ((s0 + j + k) == posmask);
        gn[k] = *(const uint4*)(gp + (size_t)(j + k + (last ? 0 : 1)) * DFF);
        const unsigned km = last ? 0u : 0xffffffffu;
        gn[k].x &= km; gn[k].y &= km; gn[k].z &= km; gn[k].w &= km;
        uu[k] = *(const uint4*)(up + (size_t)(j + k) * DFF);
      }
#pragma unroll
      for (int k = 0; k < 4; ++k) {
        const uint4 res = conv8(gm, gc, gn[k], uu[k], cb8, w0, w1, w2);
        *(uint4*)(up + (size_t)(j + k) * DFF) = res;
        gm = gc;
        gc = gn[k];
      }
    }
  }
}

#define XB_TMO      128
#define XB_XCNT(j)  (256  + 64 * (j))
#define XB_XSUB(j)  (1280 + 64 * (j))
#define XB_XGEN(j)  (2304 + 64 * (j))
#define XB_TOP      3328
#define XB_TOPGEN   3392
#define XCD_BAR_WORDS 3456
#define XB_SPIN_CAP (1u << 22)
#define LAS __attribute__((address_space(3)))
DI unsigned xb_ld(unsigned* p) { return __hip_atomic_load(p, __ATOMIC_RELAXED, __HIP_MEMORY_SCOPE_AGENT); }
DI unsigned xb_add(unsigned* p, unsigned v) { return __hip_atomic_fetch_add(p, v, __ATOMIC_RELAXED, __HIP_MEMORY_SCOPE_AGENT); }
DI unsigned xb_xcc_id() { return (unsigned)__builtin_amdgcn_s_getreg((3 << 11) | 20) & 0xFu; }
#define XB_SPIN(cond, bar) do { unsigned _sp = 0; while (cond) { __builtin_amdgcn_s_sleep(1); \
    if ((++_sp & 255u) == 0u) { if (xb_ld(&(bar)[XB_TMO])) break; if (_sp > XB_SPIN_CAP) { atomicAdd(&(bar)[XB_TMO], 1u); break; } } } } while (0)
struct XcdBarrier { unsigned* bar; unsigned x; volatile LAS unsigned* st; };
DI XcdBarrier xcd_barrier_post(unsigned* bar, volatile LAS unsigned* st) {
  XcdBarrier b; b.bar = bar; b.x = xb_xcc_id(); b.st = st;
  if (threadIdx.x == 0) (void)xb_add(&bar[XB_XCNT(b.x)], 1u);
  return b;
}
DI void xcd_barrier_complete(unsigned* bar, unsigned x, unsigned& nloc, unsigned& nx) {
  const unsigned G = gridDim.x * gridDim.y * gridDim.z;
  unsigned sum, cnt, mine, sp = 0u;
  for (;;) {
    sum = 0u; cnt = 0u; mine = 0u;
#pragma unroll
    for (unsigned j = 0; j < 16; ++j) { const unsigned c = xb_ld(&bar[XB_XCNT(j)]); sum += c; cnt += (c > 0u) ? 1u : 0u; mine = (j == x) ? c : mine; }
    if (sum == G) break;
    __builtin_amdgcn_s_sleep(1);
    if ((++sp & 255u) == 0u) { if (xb_ld(&bar[XB_TMO])) break; if (sp > XB_SPIN_CAP) { atomicAdd(&bar[XB_TMO], 1u); break; } }
  }
  nloc = mine > 0u ? mine : 1u; nx = cnt > 0u ? cnt : 1u;
}
template <bool FIRST>
DI void xcd_barrier(const XcdBarrier& b) {
  asm volatile("s_waitcnt vmcnt(0)" ::: "memory");
  __syncthreads();
  if (threadIdx.x == 0) {
    unsigned* bar = b.bar;
    __builtin_amdgcn_s_waitcnt(0);
    unsigned nloc = b.st[0], nx = b.st[1];
    if (FIRST) { xcd_barrier_complete(bar, b.x, nloc, nx); b.st[0] = nloc; b.st[1] = nx; }
    const unsigned old = xb_add(&bar[XB_XSUB(b.x)], 1u);
    const unsigned gen = old / nloc;
    if (old + 1u == (gen + 1u) * nloc) {
      __builtin_amdgcn_fence(__ATOMIC_RELEASE, "agent");
      asm volatile("s_waitcnt vmcnt(0)" ::: "memory");
      const unsigned og = xb_add(&bar[XB_TOP], 1u);
      const unsigned tg = og / nx;
      if (og + 1u == (tg + 1u) * nx) xb_add(&bar[XB_TOPGEN], 1u);
      else XB_SPIN(xb_ld(&bar[XB_TOPGEN]) == tg, bar);
      __builtin_amdgcn_fence(__ATOMIC_ACQUIRE, "agent");
      xb_add(&bar[XB_XGEN(b.x)], 1u);
      asm volatile("s_waitcnt vmcnt(0)" ::: "memory");
    } else {
      XB_SPIN(xb_ld(&bar[XB_XGEN(b.x)]) == gen, bar);
      __builtin_amdgcn_fence(__ATOMIC_ACQUIRE, "agent");
      asm volatile("s_waitcnt vmcnt(0)" ::: "memory");
    }
  }
  __syncthreads();
}

enum { PH_PREP = 0, PH_NORM1, PH_ZGEMM, PH_CQNORM, PH_QKV, PH_SCAN, PH_MIX, PH_COMBINE, PH_WO, PH_NORM2, PH_GU, PH_CONV, PH_DOWN, PH_FINAL, PH_COUNT };

template <int ph>
DI void run_phase(const Params& P, int l, int rq, char* smem, int* s_item, int dup = 0) {
  char* ws = opq(P.ws);
  const int S = rq == 0 ? 16384 : 2048;
  const int posmask = S - 1;
  float* xo = P.out + (size_t)rq * T * DM;
  const float* xcur = (l == 0) ? P.x_in[rq] : xo;
  switch (ph) {
    case PH_PREP:
#if !COOP
      if (l == 0) phase_rope(P);
#endif
      phase_prep(P, l, smem); break;
    case PH_NORM1: phase_rmsnorm_bf16(xcur, P.norm_mix + l * DM, (u16*)(ws + OFF_H)); break;
    case PH_ZGEMM: {
      EpiZ e;
      e.QA = (u16*)(ws + OFF_QA); e.KA = (u16*)(ws + OFF_KA); e.VTA = (u16*)(ws + OFF_VTA); e.CQ = (u16*)(ws + OFF_CQ);
      e.KB = (u16*)(ws + OFF_KB); e.QC = (u16*)(ws + OFF_QC); e.KC = (u16*)(ws + OFF_KC); e.KTC = (u16*)(ws + OFF_KTC);
      e.VTC = (u16*)(ws + OFF_VTC); e.G = (u16*)(ws + OFF_G);
      e.ropeA = (const float2*)(ws + OFF_ROPEA); e.ropeB = (const float2*)(ws + OFF_ROPEB); e.ropeC = (const float2*)(ws + OFF_ROPEC);
      e.posmask = posmask;
      gemm_phase<256, 256>((const u16*)(ws + OFF_H), DM, (const u16*)(ws + OFF_WT_IN), DM, T, INC, DM, smem, e, 0);
    } break;
    case PH_CQNORM: phase_cqnorm((u16*)(ws + OFF_CQ), P.mla_q_norm + l * 512, P.mla_kv_norm + l * 256); break;
    case PH_QKV: {
      EpiUQ e1;
      e1.QB = (u16*)(ws + OFF_QB); e1.ropeB = (const float2*)(ws + OFF_ROPEB); e1.posmask = posmask;
      gemm_phase<256, 256>((const u16*)(ws + OFF_CQ), 768, (const u16*)(ws + OFF_WT_UQ), 512, T, 1152, 512, smem, e1, 0);
      EpiUKV e2;
      e2.KB = (u16*)(ws + OFF_KB); e2.VTB = (u16*)(ws + OFF_VTB);
      const int g = gridDim.x;
      gemm_phase<256, 256>((const u16*)(ws + OFF_CQ) + 512, 768, (const u16*)(ws + OFF_WT_UKV), 256, T, 1536, 256, smem, e2,
                           g - (320 % g));
      const int sh = g - ((320 + 384) % g);
      for (int it = (obid() + sh) % g; it < 64 * 6; it += g) retU_item(P, l, it);
    } break;
    case PH_SCAN: phase_ret_scan(P, l, S); break;
    case PH_MIX: {
      int* cnt = (int*)(ws + OFF_CNT) + (l * 2 + rq) + 4 * dup;
      const int nA = (T / 256) * 8, nB = (T / 256) * 6, nR = 64 * 6;
      for (;;) {
        __syncthreads();
        if (otid() == 0) *s_item = atomicAdd(cnt, 1);
        __syncthreads();
        const int it = *s_item;
        if (it >= nA + nB + nR) break;
        if (it < nB) attnB_item(P, S, it, smem);
        else if (it < nB + nA) attnA_item(P, l, S, it - nB, smem);
        else retOut_item(P, l, it - nB - nA);
      }
    } break;
    case PH_COMBINE: phase_combine(P, l); break;
    case PH_WO: {
      EpiRes e;
      e.xin = xcur; e.out = xo;
      gemm_phase<256, 256>((const u16*)(ws + OFF_H), DM, (const u16*)(ws + OFF_WT_O), DM, T, DM, DM, smem, e, 0);
    } break;
    case PH_NORM2: phase_rmsnorm_bf16(xo, P.norm_ffn + l * DM, (u16*)(ws + OFF_H)); break;
    case PH_GU: {
      EpiGU e;
      e.GG = (u16*)(ws + OFF_GG); e.UU = (u16*)(ws + OFF_UU);
      gemm_phase<256, 256>((const u16*)(ws + OFF_H), DM, (const u16*)(ws + OFF_WT_GU), DM, T, 2 * DFF, DM, smem, e, 0);
    } break;
    case PH_CONV: phase_conv(P, l, posmask); break;
    case PH_DOWN: {
      EpiRes e;
      e.xin = xo; e.out = xo;
      gemm_phase<256, 256>((const u16*)(ws + OFF_UU), DFF, (const u16*)(ws + OFF_WT_DN), DFF, T, DM, DFF, smem, e, 0);
    } break;
    case PH_FINAL: phase_final_norm(xo, P.norm_final); break;
  }
}

#if COOP
__global__ void __launch_bounds__(NTHR, 2) mega_kernel(Params P) {
  extern __shared__ __attribute__((aligned(16))) char smem[];
  int* s_itemp = (int*)(smem + LDS_MAIN);
  uint4* xbw = (uint4*)(smem + LDS_MAIN + 16);
  cg::grid_group grid = cg::this_grid();
  if (threadIdx.x == 0) *xbw = make_uint4(0u, 0u, 0u, 0u);
  __syncthreads();
  XcdBarrier xb = xcd_barrier_post((unsigned*)(P.ws + OFF_BAR), (volatile LAS unsigned*)xbw);
#define GSYNC() xcd_barrier<false>(xb)
  phase_rope(P);
#pragma unroll 1
  for (int l = 0; l < 2; ++l) {
    run_phase<PH_PREP>(P, l, 0, smem, s_itemp);
    if (l == 0) { grid.sync(); xcd_barrier<true>(xb); } else GSYNC();
#pragma unroll 1
    for (int rq = 0; rq < 2; ++rq) {
      run_phase<PH_NORM1>(P, l, rq, smem, s_itemp);  GSYNC();
      run_phase<PH_ZGEMM>(P, l, rq, smem, s_itemp);  GSYNC();
      run_phase<PH_CQNORM>(P, l, rq, smem, s_itemp); GSYNC();
      run_phase<PH_QKV>(P, l, rq, smem, s_itemp);    GSYNC();
      run_phase<PH_SCAN>(P, l, rq, smem, s_itemp);   GSYNC();
      run_phase<PH_MIX>(P, l, rq, smem, s_itemp);    GSYNC();
      run_phase<PH_COMBINE>(P, l, rq, smem, s_itemp); GSYNC();
      run_phase<PH_WO>(P, l, rq, smem, s_itemp);     GSYNC();
      run_phase<PH_NORM2>(P, l, rq, smem, s_itemp);  GSYNC();
      run_phase<PH_GU>(P, l, rq, smem, s_itemp);     GSYNC();
      run_phase<PH_CONV>(P, l, rq, smem, s_itemp);   GSYNC();
      run_phase<PH_DOWN>(P, l, rq, smem, s_itemp);   GSYNC();
    }
  }
  run_phase<PH_FINAL>(P, 0, 0, smem, s_itemp);
  run_phase<PH_FINAL>(P, 0, 1, smem, s_itemp);
}
#else
template <int PH>
__global__ void __launch_bounds__(NTHR, 2) phase_kernel(Params P, int l, int rq) {
  extern __shared__ __attribute__((aligned(16))) char smem[];
  int* s_itemp = (int*)(smem + LDS_MAIN);
  run_phase<PH>(P, l, rq, smem, s_itemp);
}
#endif

extern "C" void kernel_launch(void* const* d_in, const int* in_sizes, int n_in, void* d_out, int out_size, void* d_ws,
                              size_t ws_size, hipStream_t stream) {
  Params P{};
  P.x_in[0] = (const float*)d_in[0];
  P.x_in[1] = (const float*)d_in[1];
  P.norm_mix = (const float*)d_in[2];
  P.w_in = (const float*)d_in[3];
  P.diff_lambda = (const float*)d_in[4];
  P.diff_norm = (const float*)d_in[5];
  P.mla_q_norm = (const float*)d_in[6];
  P.mla_kv_norm = (const float*)d_in[7];
  P.w_uq = (const float*)d_in[8];
  P.w_ukv = (const float*)d_in[9];
  P.ret_decay_fwd = (const float*)d_in[10];
  P.ret_decay_bwd = (const float*)d_in[11];
  P.ret_norm = (const float*)d_in[12];
  P.w_o = (const float*)d_in[13];
  P.norm_ffn = (const float*)d_in[14];
  P.w_gate = (const float*)d_in[15];
  P.w_up = (const float*)d_in[16];
  P.conv_w = (const float*)d_in[17];
  P.conv_b = (const float*)d_in[18];
  P.w_down = (const float*)d_in[19];
  P.norm_final = (const float*)d_in[20];
  P.out = (float*)d_out;
  P.ws = (char*)d_ws;
  if (ws_size < OFF_FFNEND || ws_size < OFF_MIXEND) {
    fprintf(stderr, "workspace too small: %zu\n", ws_size);
    return;
  }
  (void)hipMemsetAsync((char*)d_ws + OFF_CNT, 0, 4096 + 16384, stream);
#if COOP
  static int grid_blocks = 0;
  if (!grid_blocks) {
    int dev = 0, cus = 0, per_cu = 0;
    (void)hipGetDevice(&dev);
    (void)hipDeviceGetAttribute(&cus, hipDeviceAttributeMultiprocessorCount, dev);
    (void)hipFuncSetAttribute((const void*)mega_kernel, hipFuncAttributeMaxDynamicSharedMemorySize, DYN_LDS);
    (void)hipOccupancyMaxActiveBlocksPerMultiprocessor(&per_cu, mega_kernel, NTHR, DYN_LDS);
    if (per_cu > 1) per_cu = 1;
    if (per_cu < 1) per_cu = 1;
    grid_blocks = cus * per_cu;
  }
  void* args[] = {&P};
  hipError_t e = hipLaunchCooperativeKernel((const void*)mega_kernel, dim3(grid_blocks), dim3(NTHR), args, DYN_LDS, stream);
  if (e != hipSuccess) fprintf(stderr, "cooperative launch failed: %s (grid %d)\n", hipGetErrorString(e), grid_blocks);
#else
  const int grid = 256;
#define LP(PH, l, rq) do { (void)hipFuncSetAttribute((const void*)phase_kernel<PH>, hipFuncAttributeMaxDynamicSharedMemorySize, DYN_LDS); phase_kernel<PH><<<grid, NTHR, DYN_LDS, stream>>>(P, l, rq); } while (0)
  for (int l = 0; l < 2; ++l) {
    LP(PH_PREP, l, 0);
    for (int rq = 0; rq < 2; ++rq) {
      LP(PH_NORM1, l, rq); LP(PH_ZGEMM, l, rq); LP(PH_CQNORM, l, rq); LP(PH_QKV, l, rq); LP(PH_SCAN, l, rq); LP(PH_MIX, l, rq); LP(PH_COMBINE, l, rq);
      LP(PH_WO, l, rq); LP(PH_NORM2, l, rq); LP(PH_GU, l, rq); LP(PH_CONV, l, rq); LP(PH_DOWN, l, rq);
    }
  }
  LP(PH_FINAL, 0, 0);
  LP(PH_FINAL, 0, 1);
#endif
}
```

```cpp
#include <hip/hip_runtime.h>
#include <hip/hip_cooperative_groups.h>
#include <stdint.h>
#include <cstdio>
namespace cg = cooperative_groups;

#define DI __device__ __forceinline__
typedef unsigned short u16;
using bf16x8 = __attribute__((ext_vector_type(8))) short;
using f32x16 = __attribute__((ext_vector_type(16))) float;
typedef __bf16 bf2_t __attribute__((ext_vector_type(2)));
typedef float f2_t __attribute__((ext_vector_type(2)));
typedef unsigned u32x4 __attribute__((ext_vector_type(4)));
typedef unsigned u32x2 __attribute__((ext_vector_type(2)));
#define MFMA32(a, b, c) __builtin_amdgcn_mfma_f32_32x32x16_bf16((a), (b), (c), 0, 0, 0)

#ifndef COOP
#define COOP 1
#endif

constexpr int T = 16384;
constexpr int DM = 2048;
constexpr int INC = 4672;
constexpr int DFF = 5632;
constexpr float EPS = 1e-5f;
constexpr int NTHR = 512;
constexpr int NWAVE = NTHR / 64;
constexpr int LDS_MAIN = 131072;
constexpr int DYN_LDS = LDS_MAIN + 64;

constexpr size_t SZ_WT_IN = (size_t)INC * DM * 2;
constexpr size_t SZ_WT_UQ = (size_t)1152 * 512 * 2;
constexpr size_t SZ_WT_UKV = (size_t)1536 * 256 * 2;
constexpr size_t SZ_WT_O = (size_t)DM * DM * 2;
constexpr size_t SZ_WT_GU = (size_t)2 * DFF * DM * 2;
constexpr size_t SZ_WT_DN = (size_t)DM * DFF * 2;
constexpr size_t OFF_WT_IN = 0;
constexpr size_t OFF_WT_UQ = OFF_WT_IN + SZ_WT_IN;
constexpr size_t OFF_WT_UKV = OFF_WT_UQ + SZ_WT_UQ;
constexpr size_t OFF_WT_O = OFF_WT_UKV + SZ_WT_UKV;
constexpr size_t OFF_WT_GU = OFF_WT_O + SZ_WT_O;
constexpr size_t OFF_WT_DN = OFF_WT_GU + SZ_WT_GU;
constexpr size_t OFF_ROPEA = OFF_WT_DN + SZ_WT_DN;
constexpr size_t OFF_ROPEB = OFF_ROPEA + (size_t)16384 * 8 * 8;
constexpr size_t OFF_ROPEC = OFF_ROPEB + (size_t)16384 * 32 * 8;
constexpr size_t OFF_SCAL = OFF_ROPEC + (size_t)16384 * 32 * 8;
constexpr size_t OFF_CNT = OFF_SCAL + 4096;
constexpr size_t OFF_BAR = OFF_CNT + 4096;
constexpr size_t OFF_ACT = OFF_BAR + 16384;
constexpr size_t OFF_H = OFF_ACT;
constexpr size_t OFF_QA = OFF_H + (size_t)T * DM * 2;
constexpr size_t OFF_KA = OFF_QA + (size_t)T * 512 * 2;
constexpr size_t OFF_VTA = OFF_KA + (size_t)T * 512 * 2;
constexpr size_t OFF_CQ = OFF_VTA + (size_t)T * 512 * 2;
constexpr size_t OFF_QB = OFF_CQ + (size_t)T * 768 * 2;
constexpr size_t OFF_KB = OFF_QB + (size_t)T * 1152 * 2;
constexpr size_t OFF_VTB = OFF_KB + (size_t)T * 1152 * 2;
constexpr size_t OFF_QC = OFF_VTB + (size_t)T * 768 * 2;
constexpr size_t OFF_KC = OFF_QC + (size_t)T * 384 * 2;
constexpr size_t OFF_KTC = OFF_KC + (size_t)T * 384 * 2;
constexpr size_t OFF_VTC = OFF_KTC + (size_t)T * 384 * 2;
constexpr size_t OFF_G = OFF_VTC + (size_t)T * 768 * 2;
constexpr size_t OFF_R = OFF_G + (size_t)T * 768 * 2;
constexpr size_t OFF_O1 = OFF_R + (size_t)128 * 6 * 2 * 8192 * 2;
constexpr size_t OFF_MIXEND = OFF_O1 + (size_t)2 * T * 512 * 4;
constexpr size_t OFF_GG = OFF_H + (size_t)T * DM * 2;
constexpr size_t OFF_UU = OFF_GG + (size_t)T * DFF * 2;
constexpr size_t OFF_FFNEND = OFF_UU + (size_t)T * DFF * 2;

struct Params {
  const float* x_in[2];
  const float *norm_mix, *w_in, *diff_lambda, *diff_norm, *mla_q_norm, *mla_kv_norm, *w_uq, *w_ukv, *ret_decay_fwd,
      *ret_decay_bwd, *ret_norm, *w_o, *norm_ffn, *w_gate, *w_up, *conv_w, *conv_b, *w_down, *norm_final;
  float* out;
  char* ws;
};

DI unsigned pack2(float a, float b) {
  f2_t v = {a, b};
  bf2_t r = __builtin_convertvector(v, bf2_t);
  return __builtin_bit_cast(unsigned, r);
}
DI u16 f2bf(float a) { return (u16)(pack2(a, 0.f) & 0xffffu); }
DI float bf2f(u16 u) { return __uint_as_float(((unsigned)u) << 16); }
DI float bflo(unsigned u) { return __uint_as_float(u << 16); }
DI float bfhi(unsigned u) { return __uint_as_float(u & 0xffff0000u); }
DI int otid() { int t = threadIdx.x; asm volatile("" : "+v"(t)); return t; }
DI int obid() { int b = __builtin_amdgcn_readfirstlane((int)blockIdx.x); asm volatile("" : "+s"(b)); return b; }
DI char* opq(char* p) {
  unsigned z = 0;
  asm volatile("" : "+s"(z));
  return p + z;
}
DI int crow(int i, int h) { return (i & 3) + 8 * (i >> 2) + 4 * h; }
DI float wave_sum(float v) {
#pragma unroll
  for (int o = 32; o > 0; o >>= 1) v += __shfl_xor(v, o);
  return v;
}
DI float fexp2(float x) { return __builtin_amdgcn_exp2f(x); }
DI float silu(float x) { return x / (1.f + __expf(-x)); }
DI bf16x8 pack8(const f32x16& x, int s2) {
  uint4 u;
  u.x = pack2(x[8 * s2 + 0], x[8 * s2 + 1]);
  u.y = pack2(x[8 * s2 + 2], x[8 * s2 + 3]);
  u.z = pack2(x[8 * s2 + 4], x[8 * s2 + 5]);
  u.w = pack2(x[8 * s2 + 6], x[8 * s2 + 7]);
  return __builtin_bit_cast(bf16x8, u);
}
DI bf16x8 scale8(bf16x8 q, float s) {
  uint4 u = __builtin_bit_cast(uint4, q);
  u.x = pack2(bflo(u.x) * s, bfhi(u.x) * s);
  u.y = pack2(bflo(u.y) * s, bfhi(u.y) * s);
  u.z = pack2(bflo(u.z) * s, bfhi(u.z) * s);
  u.w = pack2(bflo(u.w) * s, bfhi(u.w) * s);
  return __builtin_bit_cast(bf16x8, u);
}
DI bf16x8 ld8(const u16* p) { return *(const bf16x8*)p; }
DI void zero16(f32x16& a) {
#pragma unroll
  for (int i = 0; i < 16; ++i) a[i] = 0.f;
}

DI void transpose_tile(const float* __restrict__ src, int N, u16* __restrict__ dst, int ldd, int kt, int nt, float* lds) {
  const int tid = otid();
  const int k0 = kt * 64, n0 = nt * 64;
  __syncthreads();
#pragma unroll
  for (int i = 0; i < 8; ++i) {
    int k = i * 8 + (tid >> 6), n = tid & 63;
    lds[k * 65 + n] = src[(size_t)(k0 + k) * N + n0 + n];
  }
  __syncthreads();
  {
    int n = (tid >> 3), kc = (tid & 7) * 8;
    uint4 u;
    u.x = pack2(lds[(kc + 0) * 65 + n], lds[(kc + 1) * 65 + n]);
    u.y = pack2(lds[(kc + 2) * 65 + n], lds[(kc + 3) * 65 + n]);
    u.z = pack2(lds[(kc + 4) * 65 + n], lds[(kc + 5) * 65 + n]);
    u.w = pack2(lds[(kc + 6) * 65 + n], lds[(kc + 7) * 65 + n]);
    *(uint4*)(dst + (size_t)(n0 + n) * ldd + k0 + kc) = u;
  }
}

DI void phase_rope(const Params& P) {
  char* ws = opq(P.ws);
    float2* ra = (float2*)(ws + OFF_ROPEA);
    float2* rb = (float2*)(ws + OFF_ROPEB);
    float2* rc = (float2*)(ws + OFF_ROPEC);
    const int n = 16384 * 72;
    for (int idx = obid() * NTHR + otid(); idx < n; idx += gridDim.x * NTHR) {
      int pos = idx / 72, f = idx % 72;
      double ex, th;
      float2* dst;
      if (f < 8) { ex = -(double)f / 8.0; th = 500000.0; dst = ra + pos * 8 + f; }
      else if (f < 40) { ex = -(double)(f - 8) / 32.0; th = 500000.0; dst = rb + pos * 32 + (f - 8); }
      else { ex = -(double)(f - 40) / 32.0; th = 10000.0; dst = rc + pos * 32 + (f - 40); }
      float inv = (float)exp2(ex * log2(th));
      float ang = (float)pos * inv;
      double rev = (double)ang * 0.15915494309189535;
      rev -= rint(rev);
      float a = (float)(rev * 6.283185307179586);
      *dst = make_float2(cosf(a), sinf(a));
    }
  }

DI void phase_prep(const Params& P, int l, char* smem) {
  float* lds = (float*)smem;
  char* ws = opq(P.ws);
  const int n_in = 32 * 73, n_uq = 8 * 18, n_ukv = 4 * 24, n_o = 32 * 32, n_g = 32 * 88, n_d = 88 * 32;
  const int total = n_in + n_uq + n_ukv + n_o + 2 * n_g + n_d;
  for (int t = obid(); t < total; t += gridDim.x) {
    int i = t;
    if (i < n_in) { transpose_tile(P.w_in + (size_t)l * DM * INC, INC, (u16*)(ws + OFF_WT_IN), DM, i / 73, i % 73, lds); continue; }
    i -= n_in;
    if (i < n_uq) { transpose_tile(P.w_uq + (size_t)l * 512 * 1152, 1152, (u16*)(ws + OFF_WT_UQ), 512, i / 18, i % 18, lds); continue; }
    i -= n_uq;
    if (i < n_ukv) { transpose_tile(P.w_ukv + (size_t)l * 256 * 1536, 1536, (u16*)(ws + OFF_WT_UKV), 256, i / 24, i % 24, lds); continue; }
    i -= n_ukv;
    if (i < n_o) { transpose_tile(P.w_o + (size_t)l * DM * DM, DM, (u16*)(ws + OFF_WT_O), DM, i / 32, i % 32, lds); continue; }
    i -= n_o;
    if (i < n_g) { transpose_tile(P.w_gate + (size_t)l * DM * DFF, DFF, (u16*)(ws + OFF_WT_GU), DM, i / 88, i % 88, lds); continue; }
    i -= n_g;
    if (i < n_g) { transpose_tile(P.w_up + (size_t)l * DM * DFF, DFF, (u16*)(ws + OFF_WT_GU) + (size_t)DFF * DM, DM, i / 88, i % 88, lds); continue; }
    i -= n_g;
    transpose_tile(P.w_down + (size_t)l * DFF * DM, DM, (u16*)(ws + OFF_WT_DN), DFF, i / 32, i % 32, lds);
  }
  if (obid() == 0) {
    float* scal = (float*)(ws + OFF_SCAL) + l * 32;
    const int tid = otid();
    if (tid < 64) {
      const float* lp = P.diff_lambda + (size_t)l * 256;
      float a = lp[tid] * lp[64 + tid];
      float b = lp[128 + tid] * lp[192 + tid];
      a = wave_sum(a);
      b = wave_sum(b);
      if (tid == 0) {
        float lam_init = 0.8f - 0.6f * expf(-0.3f * (float)l);
        scal[0] = expf(a) - expf(b) + lam_init;
        scal[1] = 1.0f - lam_init;
      }
      if (tid < 6) {
        float xf = P.ret_decay_fwd[l * 6 + tid], xb = P.ret_decay_bwd[l * 6 + tid];
        scal[2 + tid] = -log1pf(expf(-xf)) * 1.4426950408889634f;
        scal[8 + tid] = -log1pf(expf(-xb)) * 1.4426950408889634f;
      }
    }
  }
}

DI void phase_rmsnorm_bf16(const float* __restrict__ x, const float* __restrict__ g, u16* __restrict__ h) {
  const int lane = otid() & 63, w = otid() >> 6;
  for (int row = obid() * NWAVE + w; row < T; row += gridDim.x * NWAVE) {
    const float4* xr = (const float4*)(x + (size_t)row * DM);
    float4 v[8];
    float ss = 0.f;
#pragma unroll
    for (int i = 0; i < 8; ++i) {
      v[i] = xr[lane + 64 * i];
      ss += v[i].x * v[i].x + v[i].y * v[i].y + v[i].z * v[i].z + v[i].w * v[i].w;
    }
    ss = wave_sum(ss);
    const float rstd = rsqrtf(ss * (1.f / DM) + EPS);
#pragma unroll
    for (int i = 0; i < 8; ++i) {
      float4 g4 = ((const float4*)g)[lane + 64 * i];
      uint2 o;
      o.x = pack2(v[i].x * rstd * g4.x, v[i].y * rstd * g4.y);
      o.y = pack2(v[i].z * rstd * g4.z, v[i].w * rstd * g4.w);
      *(uint2*)(h + (size_t)row * DM + (lane + 64 * i) * 4) = o;
    }
  }
}

DI void phase_final_norm(float* __restrict__ x, const float* __restrict__ g) {
  const int lane = otid() & 63, w = otid() >> 6;
  for (int row = obid() * NWAVE + w; row < T; row += gridDim.x * NWAVE) {
    float4* xr = (float4*)(x + (size_t)row * DM);
    float4 v[8];
    float ss = 0.f;
#pragma unroll
    for (int i = 0; i < 8; ++i) {
      v[i] = xr[lane + 64 * i];
      ss += v[i].x * v[i].x + v[i].y * v[i].y + v[i].z * v[i].z + v[i].w * v[i].w;
    }
    ss = wave_sum(ss);
    const float rstd = rsqrtf(ss * (1.f / DM) + EPS);
#pragma unroll
    for (int i = 0; i < 8; ++i) {
      float4 g4 = ((const float4*)g)[lane + 64 * i];
      float4 o = make_float4(v[i].x * rstd * g4.x, v[i].y * rstd * g4.y, v[i].z * rstd * g4.z, v[i].w * rstd * g4.w);
      xr[lane + 64 * i] = o;
    }
  }
}

DI void phase_cqnorm(u16* __restrict__ cq, const float* __restrict__ gq, const float* __restrict__ gkv) {
  const int lane = otid() & 63, w = otid() >> 6;
  for (int row = obid() * NWAVE + w; row < T; row += gridDim.x * NWAVE) {
    u16* p = cq + (size_t)row * 768;
    uint4 a = *(const uint4*)(p + lane * 8);
    uint2 b = *(const uint2*)(p + 512 + lane * 4);
    float qa[8] = {bflo(a.x), bfhi(a.x), bflo(a.y), bfhi(a.y), bflo(a.z), bfhi(a.z), bflo(a.w), bfhi(a.w)};
    float kb[4] = {bflo(b.x), bfhi(b.x), bflo(b.y), bfhi(b.y)};
    float s1 = 0.f, s2 = 0.f;
#pragma unroll
    for (int i = 0; i < 8; ++i) s1 += qa[i] * qa[i];
#pragma unroll
    for (int i = 0; i < 4; ++i) s2 += kb[i] * kb[i];
    s1 = wave_sum(s1);
    s2 = wave_sum(s2);
    const float r1 = rsqrtf(s1 * (1.f / 512.f) + EPS), r2 = rsqrtf(s2 * (1.f / 256.f) + EPS);
    float4 g0 = ((const float4*)gq)[lane * 2], g1 = ((const float4*)gq)[lane * 2 + 1], g2 = ((const float4*)gkv)[lane];
    uint4 oa;
    oa.x = pack2(qa[0] * r1 * g0.x, qa[1] * r1 * g0.y);
    oa.y = pack2(qa[2] * r1 * g0.z, qa[3] * r1 * g0.w);
    oa.z = pack2(qa[4] * r1 * g1.x, qa[5] * r1 * g1.y);
    oa.w = pack2(qa[6] * r1 * g1.z, qa[7] * r1 * g1.w);
    uint2 ob;
    ob.x = pack2(kb[0] * r2 * g2.x, kb[1] * r2 * g2.y);
    ob.y = pack2(kb[2] * r2 * g2.z, kb[3] * r2 * g2.w);
    *(uint4*)(p + lane * 8) = oa;
    *(uint2*)(p + 512 + lane * 4) = ob;
  }
}

DI void store_T(u16* __restrict__ base, int col, int rb, int h, const f32x16& v) {
#pragma unroll
  for (int g = 0; g < 4; ++g) {
    uint2 pk;
    pk.x = pack2(v[4 * g], v[4 * g + 1]);
    pk.y = pack2(v[4 * g + 2], v[4 * g + 3]);
    *(uint2*)(base + (size_t)col * T + rb + 8 * g + 4 * h) = pk;
  }
}

struct EpiZ {
  u16 *QA, *KA, *VTA, *CQ, *KB, *QC, *KC, *KTC, *VTC, *G;
  const float2 *ropeA, *ropeB, *ropeC;
  int posmask;
  DI void operator()(int rb, int c64, const f32x16& v0, const f32x16& v1) const {
    if (c64 >= INC) return;
    const int lane = otid() & 63, r = lane & 31, h = lane >> 5;
    if (c64 < 1024) {
      u16* dst = (c64 < 512) ? QA : KA;
      const int cc = c64 & 511;
#pragma unroll
      for (int i = 0; i < 16; ++i) {
        const int t = rb + crow(i, h);
        float x = v0[i];
        float ot = __shfl_xor(x, 8);
        if (r < 16) {
          float2 cs = ropeA[(t & posmask) * 8 + (r & 7)];
          x = (r < 8) ? (x * cs.x - ot * cs.y) : (x * cs.x + ot * cs.y);
        }
        dst[(size_t)t * 512 + cc + r] = f2bf(x);
        dst[(size_t)t * 512 + cc + 32 + r] = f2bf(v1[i]);
      }
    } else if (c64 < 1536) {
      store_T(VTA, c64 - 1024 + r, rb, h, v0);
      store_T(VTA, c64 - 1024 + 32 + r, rb, h, v1);
    } else if (c64 < 2304) {
      const int cc = c64 - 1536;
#pragma unroll
      for (int i = 0; i < 16; ++i) {
        const int t = rb + crow(i, h);
        CQ[(size_t)t * 768 + cc + r] = f2bf(v0[i]);
        CQ[(size_t)t * 768 + cc + 32 + r] = f2bf(v1[i]);
      }
    } else if (c64 < 2368) {
#pragma unroll
      for (int i = 0; i < 16; ++i) {
        const int t = rb + crow(i, h);
        float2 cs = ropeB[(t & posmask) * 32 + r];
        u16 o0 = f2bf(v0[i] * cs.x - v1[i] * cs.y), o1 = f2bf(v1[i] * cs.x + v0[i] * cs.y);
#pragma unroll
        for (int hh = 0; hh < 6; ++hh) {
          KB[(size_t)t * 1152 + hh * 192 + 128 + r] = o0;
          KB[(size_t)t * 1152 + hh * 192 + 160 + r] = o1;
        }
      }
    } else if (c64 < 2752) {
      const int cc = c64 - 2368;
#pragma unroll
      for (int i = 0; i < 16; ++i) {
        const int t = rb + crow(i, h);
        float2 cs = ropeC[(t & posmask) * 32 + r];
        QC[(size_t)t * 384 + cc + r] = f2bf(v0[i] * cs.x - v1[i] * cs.y);
        QC[(size_t)t * 384 + cc + 32 + r] = f2bf(v1[i] * cs.x + v0[i] * cs.y);
      }
    } else if (c64 < 3136) {
      const int cc = c64 - 2752;
      f32x16 o0, o1;
#pragma unroll
      for (int i = 0; i < 16; ++i) {
        const int t = rb + crow(i, h);
        float2 cs = ropeC[(t & posmask) * 32 + r];
        o0[i] = (v0[i] * cs.x - v1[i] * cs.y) * 0.125f;
        o1[i] = (v1[i] * cs.x + v0[i] * cs.y) * 0.125f;
        KC[(size_t)t * 384 + cc + r] = f2bf(o0[i]);
        KC[(size_t)t * 384 + cc + 32 + r] = f2bf(o1[i]);
      }
      store_T(KTC, cc + r, rb, h, o0);
      store_T(KTC, cc + 32 + r, rb, h, o1);
    } else if (c64 < 3904) {
      store_T(VTC, c64 - 3136 + r, rb, h, v0);
      store_T(VTC, c64 - 3136 + 32 + r, rb, h, v1);
    } else {
      const int cc = c64 - 3904;
#pragma unroll
      for (int i = 0; i < 16; ++i) {
        const int t = rb + crow(i, h);
        G[(size_t)t * 768 + cc + r] = f2bf(silu(v0[i]));
        G[(size_t)t * 768 + cc + 32 + r] = f2bf(silu(v1[i]));
      }
    }
  }
};

struct EpiUQ {
  u16* QB;
  const float2* ropeB;
  int posmask;
  DI void operator()(int rb, int c64, const f32x16& v0, const f32x16& v1) const {
    const int lane = otid() & 63, r = lane & 31, h = lane >> 5;
    const bool isrope = ((c64 >> 6) % 3) == 2;
#pragma unroll
    for (int i = 0; i < 16; ++i) {
      const int t = rb + crow(i, h);
      float a = v0[i], b = v1[i];
      if (isrope) {
        float2 cs = ropeB[(t & posmask) * 32 + r];
        float na = a * cs.x - b * cs.y, nb = b * cs.x + a * cs.y;
        a = na; b = nb;
      }
      QB[(size_t)t * 1152 + c64 + r] = f2bf(a);
      QB[(size_t)t * 1152 + c64 + 32 + r] = f2bf(b);
    }
  }
};

struct EpiUKV {
  u16 *KB, *VTB;
  DI void operator()(int rb, int c64, const f32x16& v0, const f32x16& v1) const {
    const int lane = otid() & 63, r = lane & 31, h = lane >> 5;
    const int g = c64 >> 6, head = g >> 2, part = g & 3;
    if (part < 2) {
#pragma unroll
      for (int i = 0; i < 16; ++i) {
        const int t = rb + crow(i, h);
        KB[(size_t)t * 1152 + head * 192 + part * 64 + r] = f2bf(v0[i]);
        KB[(size_t)t * 1152 + head * 192 + part * 64 + 32 + r] = f2bf(v1[i]);
      }
    } else {
      const int e = head * 128 + (part - 2) * 64 + r;
      store_T(VTB, e, rb, h, v0);
      store_T(VTB, e + 32, rb, h, v1);
    }
  }
};

struct EpiRes {
  const float* xin;
  float* out;
  DI void operator()(int rb, int c64, const f32x16& v0, const f32x16& v1) const {
    const int lane = otid() & 63, r = lane & 31, h = lane >> 5;
    const size_t o0 = (size_t)(rb + 4 * h) * DM + c64 + r;
    float a0[16], a1[16];
#pragma unroll
    for (int i = 0; i < 16; ++i) {
      const size_t o = o0 + (size_t)((i & 3) + 8 * (i >> 2)) * DM;
      a0[i] = xin[o];
      a1[i] = xin[o + 32];
    }
#pragma unroll
    for (int i = 0; i < 16; ++i) {
      const size_t o = o0 + (size_t)((i & 3) + 8 * (i >> 2)) * DM;
      out[o] = a0[i] + v0[i];
      out[o + 32] = a1[i] + v1[i];
    }
  }
};

struct EpiGU {
  u16 *GG, *UU;
  DI void operator()(int rb, int c64, const f32x16& v0, const f32x16& v1) const {
    const int lane = otid() & 63, r = lane & 31, h = lane >> 5;
    u16* dst = (c64 < DFF) ? GG : UU;
    const int cc = (c64 < DFF) ? c64 : c64 - DFF;
#pragma unroll
    for (int i = 0; i < 16; ++i) {
      const size_t o = (size_t)(rb + crow(i, h)) * DFF + cc + r;
      dst[o] = f2bf(v0[i]);
      dst[o + 32] = f2bf(v1[i]);
    }
  }
};

template <int BM, int BN, class Epi>
DI void gemm_phase(const u16* __restrict__ A, int lda, const u16* __restrict__ Bt, int ldb, int M, int N, int K,
                   char* smem, const Epi& epi, int shift) {
  constexpr int WM = BM / 2, WN = BN / 4, MI = WM / 32, NI = WN / 32;
  constexpr int A_BYTES = BM * 128, B_BYTES = BN * 128, STAGE = A_BYTES + B_BYTES;
  constexpr int NGA = BM / (8 * NWAVE), NGB = BN / (8 * NWAVE);
  static_assert(2 * STAGE <= 131072, "lds");
  static_assert((NGA % 2) == 0 && (NGB % 2) == 0, "piece parity");
  const int tid = otid(), lane = tid & 63, r = lane & 31, h = lane >> 5;
  const int wv = __builtin_amdgcn_readfirstlane(tid >> 6);
  const int wm = wv >> 2, wn = wv & 3;
  const int mtiles = M / BM, ntiles = (N + BN - 1) / BN, total = mtiles * ntiles;
  const int nk = K / 64;
  const int grid = gridDim.x;
  const int vb = (obid() + shift) % grid;
  const int ntl = (vb < total) ? (total - vb + grid - 1) / grid : 0;
  const int nIter = ntl * nk;
  const int cE = (lane & 7) ^ ((lane >> 4) & 7), cO = (lane & 7) ^ (((lane >> 4) + 4) & 7);
  const unsigned offAE = (unsigned)((lane >> 3) * lda + cE * 8) * 2u, offAO = (unsigned)((lane >> 3) * lda + cO * 8) * 2u;
  const unsigned offBE = (unsigned)((lane >> 3) * ldb + cE * 8) * 2u, offBO = (unsigned)((lane >> 3) * ldb + cO * 8) * 2u;
  const int sw = (r >> 1) & 7;
  unsigned fo[4];
#pragma unroll
  for (int ks = 0; ks < 4; ++ks) fo[ks] = (unsigned)(r * 128 + (((ks * 2 + h) ^ sw) * 16));

  int p_t = 0, p_k = 0, p_it = 0;
  auto issue = [&]() {
    const int tile = vb + p_t * grid;
    const int sup = tile / (32 * ntiles), rem = tile % (32 * ntiles);
    const int nt = rem / 32, mt = sup * 32 + (rem % 32);
    const int m0 = mt * BM, n0 = nt * BN;
    char* st = smem + (p_it & 1) * STAGE;
#pragma unroll
    for (int i = 0; i < NGA; ++i) {
      const int rowb = m0 + (wv * NGA + i) * 8;
      const char* g = (const char*)(A + (size_t)rowb * lda + p_k * 64) + ((i & 1) ? offAO : offAE);
      __builtin_amdgcn_global_load_lds((const unsigned*)g, (__attribute__((address_space(3))) unsigned*)(st + (wv * NGA + i) * 1024), 16, 0, 0);
    }
#pragma unroll
    for (int i = 0; i < NGB; ++i) {
      int rowb = n0 + (wv * NGB + i) * 8;
      rowb = rowb <= N - 8 ? rowb : N - 8;
      const char* g = (const char*)(Bt + (size_t)rowb * ldb + p_k * 64) + ((i & 1) ? offBO : offBE);
      __builtin_amdgcn_global_load_lds((const unsigned*)g, (__attribute__((address_space(3))) unsigned*)(st + A_BYTES + (wv * NGB + i) * 1024), 16, 0, 0);
    }
    ++p_it;
    if (++p_k == nk) { p_k = 0; ++p_t; }
  };

  f32x16 acc[MI][NI];
#pragma unroll
  for (int i = 0; i < MI; ++i)
#pragma unroll
    for (int j = 0; j < NI; ++j) zero16(acc[i][j]);

  asm volatile("s_waitcnt vmcnt(0)" ::: "memory");
  __syncthreads();
  bf16x8 fa[2][MI], fb[2][NI];
#define GEMM_LDFRAG(set_, base_, ks_) { const char* As_ = (base_) + (wm * WM) * 128; const char* Bs_ = (base_) + A_BYTES + (wn * WN) * 128; \
    _Pragma("unroll") for (int j = 0; j < NI; ++j) fb[set_][j] = *(const bf16x8*)(Bs_ + j * 4096 + fo[ks_]); \
    _Pragma("unroll") for (int i = 0; i < MI; ++i) fa[set_][i] = *(const bf16x8*)(As_ + i * 4096 + fo[ks_]); }
#define GEMM_MMA(set_) { __builtin_amdgcn_sched_barrier(0); __builtin_amdgcn_s_setprio(1); \
    _Pragma("unroll") for (int i = 0; i < MI; ++i) _Pragma("unroll") for (int j = 0; j < NI; ++j) acc[i][j] = MFMA32(fa[set_][i], fb[set_][j], acc[i][j]); \
    __builtin_amdgcn_s_setprio(0); __builtin_amdgcn_sched_barrier(0); }
  if (nIter > 0) issue();
  if (nIter > 1) issue();
  if (nIter > 0) {
    if (nIter > 1) asm volatile("s_waitcnt vmcnt(%0)" ::"n"(NGA + NGB) : "memory");
    else asm volatile("s_waitcnt vmcnt(0)" ::: "memory");
    __builtin_amdgcn_s_barrier();
    GEMM_LDFRAG(0, smem, 0);
  }
  __builtin_amdgcn_s_waitcnt(0xC07F);
  int c_t = 0, c_k = 0;
  for (int it = 0; it < nIter; ++it) {
    const char* base = smem + (it & 1) * STAGE;
    GEMM_LDFRAG(1, base, 1);
    GEMM_MMA(0);
    GEMM_LDFRAG(0, base, 2);
    GEMM_MMA(1);
    GEMM_LDFRAG(1, base, 3);
    GEMM_MMA(0);
    __builtin_amdgcn_s_waitcnt(0xC07F);
    asm volatile("s_waitcnt vmcnt(0)" ::: "memory");
    __builtin_amdgcn_s_barrier();
    if (it + 2 < nIter) issue();
    if (it + 1 < nIter) { GEMM_LDFRAG(0, smem + ((it + 1) & 1) * STAGE, 0); }
    GEMM_MMA(1);
    __builtin_amdgcn_s_waitcnt(0xC07F);
    if (++c_k == nk) {
      c_k = 0;
      const int tile = vb + c_t * grid;
      ++c_t;
      const int sup = tile / (32 * ntiles), rem = tile % (32 * ntiles);
      const int nt = rem / 32, mt = sup * 32 + (rem % 32);
      const int m0 = mt * BM, n0 = nt * BN;
#pragma unroll
      for (int i = 0; i < MI; ++i)
#pragma unroll
        for (int j = 0; j < NI; j += 2) {
          if (n0 + wn * WN + j * 32 < N) epi(m0 + wm * WM + i * 32, n0 + wn * WN + j * 32, acc[i][j], acc[i][j + 1]);
          zero16(acc[i][j]);
          zero16(acc[i][j + 1]);
        }
    }
  }
#undef GEMM_LDFRAG
#undef GEMM_MMA
  __syncthreads();
}

template <int DK, int NB>
DI void attn_ldk(const u16* __restrict__ Ks, int ks0, int pr, int h, bf16x8 (&kf)[2 * NB]) {
  constexpr int LDKK = DK + 8;
#pragma unroll
  for (int j = 0; j < NB; ++j)
#pragma unroll
    for (int kb = 0; kb < 2; ++kb) kf[j * 2 + kb] = ld8(Ks + (kb * 32 + pr) * LDKK + (ks0 + j) * 16 + h * 8);
}
template <int DK, int NB>
DI void attn_mmaqk(const bf16x8 (&kf)[2 * NB], const bf16x8 (&qf)[DK / 16], int ks0, f32x16 (&s)[2]) {
  __builtin_amdgcn_sched_barrier(0);
#pragma unroll
  for (int j = 0; j < NB; ++j)
#pragma unroll
    for (int kb = 0; kb < 2; ++kb) s[kb] = MFMA32(kf[j * 2 + kb], qf[ks0 + j], s[kb]);
  __builtin_amdgcn_sched_barrier(0);
}
template <int DK>
DI void attn_qk_full(const u16* __restrict__ Ks, const bf16x8 (&qf)[DK / 16], int pr, int h, f32x16 (&s)[2]) {
  constexpr int KS = DK / 16, NB = 2, NBATCH = KS / NB;
  bf16x8 kf[2][2 * NB];
  attn_ldk<DK, NB>(Ks, 0, pr, h, kf[0]);
#pragma unroll
  for (int b = 0; b < NBATCH; ++b) {
    if (b + 1 < NBATCH) attn_ldk<DK, NB>(Ks, (b + 1) * NB, pr, h, kf[(b + 1) & 1]);
    attn_mmaqk<DK, NB>(kf[b & 1], qf, b * NB, s);
  }
}
DI float attn_exp(f32x16& s, float c, float m, bf16x8& p0, bf16x8& p1) {
  float ps = 0.f;
#pragma unroll
  for (int i = 0; i < 16; ++i) {
    float p = fexp2(fmaf(s[i], c, -m));
    s[i] = p;
    ps += p;
  }
  p0 = pack8(s, 0);
  p1 = pack8(s, 1);
  return ps;
}
DI void attn_ldv(const u16* __restrict__ Vs, int kb, int r, int h, bf16x8 (&vf)[8]) {
#pragma unroll
  for (int s2 = 0; s2 < 2; ++s2)
#pragma unroll
    for (int e = 0; e < 4; ++e) vf[s2 * 4 + e] = ld8(Vs + (e * 32 + r) * 72 + (kb * 2 + s2) * 16 + h * 8);
}
DI void attn_mmapv(const bf16x8 (&vf)[8], const bf16x8& p0, const bf16x8& p1, f32x16 (&o)[4]) {
  __builtin_amdgcn_sched_barrier(0);
#pragma unroll
  for (int e = 0; e < 4; ++e) o[e] = MFMA32(vf[e], p0, o[e]);
#pragma unroll
  for (int e = 0; e < 4; ++e) o[e] = MFMA32(vf[4 + e], p1, o[e]);
  __builtin_amdgcn_sched_barrier(0);
}

template <int DK>
DI void attn_pass(const u16* __restrict__ Qp, const u16* __restrict__ Kp, int ldk, const u16* __restrict__ Vt, int ntiles,
                  float c, char* smem, f32x16 (&o)[4], float& l_out) {
  constexpr bool PIPE = (DK == 64);
  constexpr int KS = DK / 16, LDKK = DK + 8, NKC = DK / 64;
  constexpr int KSTG = 64 * LDKK, VSTG = 128 * 72;
  static_assert((3 * KSTG + 2 * VSTG) * 2 <= LDS_MAIN, "lds");
  const int tid = otid(), lane = tid & 63, r = lane & 31, h = lane >> 5;
  const int pr = (r & 19) | ((r & 4) << 1) | ((r & 8) >> 1);
  bf16x8 qf[KS];
#pragma unroll
  for (int ks = 0; ks < KS; ++ks) qf[ks] = ld8(Qp + ks * 16 + h * 8);
  u16* Kl = (u16*)smem;
  u16* Vl = Kl + 3 * KSTG;
  const u16* kg = Kp + (size_t)(tid >> 3) * ldk + (tid & 7) * 8;
  const u16* vg = Vt + (size_t)(tid >> 2) * T + (tid & 3) * 16;
  const int klo = (tid >> 3) * LDKK + (tid & 7) * 8;
  const int vlo = (tid >> 2) * 72 + (tid & 3) * 16;
  constexpr int NSET = (DK == 64) ? 2 : 1;
  u32x4 kreg[NSET][NKC], vreg[NSET][2];
#define ATT_GLOADK(set_, tile_) { const int tn_ = (tile_) < ntiles ? (tile_) : ntiles - 1; const u16* kg2_ = kg + (size_t)tn_ * 64 * ldk; \
    _Pragma("unroll") for (int i = 0; i < NKC; ++i) kreg[set_][i] = *(const u32x4*)(kg2_ + i * 64); }
#define ATT_GLOADV(set_, tile_) { const int tn_ = (tile_) < ntiles ? (tile_) : ntiles - 1; const u16* vg2_ = vg + tn_ * 64; \
    _Pragma("unroll") for (int i = 0; i < 2; ++i) vreg[set_][i] = *(const u32x4*)(vg2_ + i * 8); }
#define ATT_WRITEK(set_, st_) { u16* sb_ = Kl + (st_) * KSTG + klo; _Pragma("unroll") for (int i = 0; i < NKC; ++i) *(u32x4*)(sb_ + i * 64) = kreg[set_][i]; }
#define ATT_WRITEV(set_, st_) { u16* sb_ = Vl + (st_) * VSTG + vlo; _Pragma("unroll") for (int i = 0; i < 2; ++i) *(u32x4*)(sb_ + i * 8) = vreg[set_][i]; }
  float m = -1e30f, l = 0.f;
#pragma unroll
  for (int e = 0; e < 4; ++e) zero16(o[e]);
  __syncthreads();
  if constexpr (NSET == 2) {
    ATT_GLOADK(0, 0); ATT_GLOADV(0, 0); ATT_GLOADK(1, 1);
    ATT_WRITEK(0, 0); ATT_WRITEV(0, 0); ATT_WRITEK(1, 1);
    ATT_GLOADK(0, 2); ATT_GLOADK(1, 3); ATT_GLOADV(0, 1); ATT_GLOADV(1, 2);
  } else {
    ATT_GLOADK(0, 0); ATT_GLOADV(0, 0);
    ATT_WRITEK(0, 0); ATT_WRITEV(0, 0);
    ATT_GLOADK(0, 1);
    ATT_WRITEK(0, 1);
    ATT_GLOADK(0, 2); ATT_GLOADV(0, 1);
  }
  __syncthreads();
  f32x16 s[2], sn[2];
  if constexpr (PIPE) {
    zero16(s[0]); zero16(s[1]);
    attn_qk_full<DK>(Kl, qf, pr, h, s);
  }
  int kst0 = 0, kst1 = 1, kst2 = 2;
#define ATT_TILE(SET_, tile_) { \
    ATT_WRITEK((SET_) % NSET, kst2); \
    ATT_WRITEV((SET_) % NSET, ((tile_) + 1) & 1); \
    ATT_GLOADK((SET_) % NSET, (tile_) + 2 + NSET); ATT_GLOADV((SET_) % NSET, (tile_) + 1 + NSET); \
    __builtin_amdgcn_sched_barrier(0); \
    const u16* Vs = Vl + ((tile_) & 1) * VSTG; \
    bf16x8 kfp[8]; \
    if constexpr (PIPE) attn_ldk<DK, 4>(Kl + kst1 * KSTG, 0, pr, h, kfp);     \
    if constexpr (!PIPE) { \
      zero16(s[0]); zero16(s[1]); \
      attn_qk_full<DK>(Kl + kst0 * KSTG, qf, pr, h, s); \
    } \
    bf16x8 vf[8]; \
    if constexpr (!PIPE) attn_ldv(Vs, 0, r, h, vf);                         \
    __builtin_amdgcn_sched_barrier(0); \
    float mx = -1e30f; \
    _Pragma("unroll") for (int kb = 0; kb < 2; ++kb) _Pragma("unroll") for (int i = 0; i < 16; ++i) mx = fmaxf(mx, s[kb][i]); \
    mx = fmaxf(mx, __shfl_xor(mx, 32)); \
    float mn = fmaxf(m, mx * c); \
    const bool need = __builtin_amdgcn_readfirstlane(__ballot(mn - m > 6.0f) != 0ull); \
    if (need) { \
      const float alpha = fexp2(m - mn); \
      m = mn; \
      l *= alpha; \
      _Pragma("unroll") for (int e = 0; e < 4; ++e) _Pragma("unroll") for (int i = 0; i < 16; ++i) o[e][i] *= alpha; \
    } \
    bf16x8 p0, p1; \
    if constexpr (PIPE) { \
      zero16(sn[0]); zero16(sn[1]); \
      attn_mmaqk<DK, 4>(kfp, qf, 0, sn); \
      attn_ldv(Vs, 0, r, h, vf);                                             \
      __builtin_amdgcn_sched_barrier(0); \
    } \
    float ps = attn_exp(s[0], c, m, p0, p1); \
    attn_mmapv(vf, p0, p1, o); \
    attn_ldv(Vs, 1, r, h, vf);                                               \
    __builtin_amdgcn_sched_barrier(0); \
    ps += attn_exp(s[1], c, m, p0, p1); \
    attn_mmapv(vf, p0, p1, o); \
    ps += __shfl_xor(ps, 32); \
    l += ps; \
    __syncthreads(); \
    if constexpr (PIPE) { s[0] = sn[0]; s[1] = sn[1]; } \
    kst0 = kst1; \
    kst1 = kst2; \
    kst2 = (kst1 + 1) % 3; }
  for (int tile = 0; tile < ntiles; tile += 2) {
    ATT_TILE(0, tile)
    ATT_TILE(1, tile + 1)
  }
#undef ATT_TILE
#undef ATT_GLOADK
#undef ATT_GLOADV
#undef ATT_WRITEK
#undef ATT_WRITEV
  l_out = l;
}

DI void attnA_item(const Params& P, int l, int S, int item, char* smem) {
  char* ws = opq(P.ws);
  const int nqb = S / 256;
  const int qb = item % nqb, hm = (item / nqb) % 8, seq = item / (nqb * 8);
  const int head = hm >> 1, map = hm & 1;
  const int tid = otid(), lane = tid & 63, w = tid >> 6, r = lane & 31, h = lane >> 5;
  const int q0 = seq * S + qb * 256, kv0 = seq * S;
  const u16* QA = (const u16*)(ws + OFF_QA);
  const u16* KA = (const u16*)(ws + OFF_KA);
  const u16* VTA = (const u16*)(ws + OFF_VTA);
  const int tok = q0 + w * 32 + r;
  const float c = 0.125f * 1.4426950408889634f;
  float* os = (float*)(ws + OFF_O1) + (size_t)map * T * 512 + (size_t)tok * 512 + head * 128;
  f32x16 o1[4];
  float l1;
  attn_pass<64>(QA + (size_t)tok * 512 + head * 128 + map * 64, KA + (size_t)kv0 * 512 + head * 128 + map * 64, 512,
                VTA + (size_t)(head * 128) * T + kv0, S / 64, c, smem, o1, l1);
  const float i1 = 1.f / l1;
#pragma unroll
  for (int e = 0; e < 4; ++e)
#pragma unroll
    for (int g = 0; g < 4; ++g) {
      const int e0 = e * 32 + 8 * g + 4 * h;
      *(float4*)(os + e0) = make_float4(o1[e][4 * g] * i1, o1[e][4 * g + 1] * i1, o1[e][4 * g + 2] * i1, o1[e][4 * g + 3] * i1);
    }
}

DI void phase_combine(const Params& P, int l) {
  char* ws = opq(P.ws);
  const float* scal = (const float*)(ws + OFF_SCAL) + l * 32;
  const float lam = scal[0], oml = scal[1];
  const float* O1 = (const float*)(ws + OFF_O1);
  const float* O2 = O1 + (size_t)T * 512;
  u16* mix = (u16*)(ws + OFF_H);
  const float* dn = P.diff_norm + l * 128;
  const int lane = otid() & 63, w = otid() >> 6;
  const int col = lane * 8;
  const float4 g0 = *(const float4*)(dn + (col & 127)), g1 = *(const float4*)(dn + (col & 127) + 4);
  for (int tok = obid() * NWAVE + w; tok < T; tok += gridDim.x * NWAVE) {
    const float4 a0 = *(const float4*)(O1 + (size_t)tok * 512 + col), a1 = *(const float4*)(O1 + (size_t)tok * 512 + col + 4);
    const float4 b0 = *(const float4*)(O2 + (size_t)tok * 512 + col), b1 = *(const float4*)(O2 + (size_t)tok * 512 + col + 4);
    float v[8] = {a0.x - lam * b0.x, a0.y - lam * b0.y, a0.z - lam * b0.z, a0.w - lam * b0.w,
                  a1.x - lam * b1.x, a1.y - lam * b1.y, a1.z - lam * b1.z, a1.w - lam * b1.w};
    float ss = 0.f;
#pragma unroll
    for (int k = 0; k < 8; ++k) ss += v[k] * v[k];
    ss += __shfl_xor(ss, 1);
    ss += __shfl_xor(ss, 2);
    ss += __shfl_xor(ss, 4);
    ss += __shfl_xor(ss, 8);
    const float rstd = rsqrtf(ss * (1.f / 128.f) + EPS) * oml;
    uint4 pk;
    pk.x = pack2(v[0] * rstd * g0.x, v[1] * rstd * g0.y);
    pk.y = pack2(v[2] * rstd * g0.z, v[3] * rstd * g0.w);
    pk.z = pack2(v[4] * rstd * g1.x, v[5] * rstd * g1.y);
    pk.w = pack2(v[6] * rstd * g1.z, v[7] * rstd * g1.w);
    *(uint4*)(mix + (size_t)tok * DM + col) = pk;
  }
}

DI void attnB_item(const Params& P, int S, int item, char* smem) {
  char* ws = opq(P.ws);
  const int nqb = S / 256;
  const int qb = item % nqb, head = (item / nqb) % 6, seq = item / (nqb * 6);
  const int tid = otid(), lane = tid & 63, w = tid >> 6, r = lane & 31, h = lane >> 5;
  const int q0 = seq * S + qb * 256, kv0 = seq * S;
  const u16* QB = (const u16*)(ws + OFF_QB);
  const u16* KB = (const u16*)(ws + OFF_KB);
  const u16* VTB = (const u16*)(ws + OFF_VTB);
  const int tok = q0 + w * 32 + r;
  const float c = 0.07216878364870323f * 1.4426950408889634f;
  f32x16 o[4];
  float lsum;
  attn_pass<192>(QB + (size_t)tok * 1152 + head * 192, KB + (size_t)kv0 * 1152 + head * 192, 1152,
                 VTB + (size_t)(head * 128) * T + kv0, S / 64, c, smem, o, lsum);
  const float il = 1.f / lsum;
  u16* mix = (u16*)(ws + OFF_H);
#pragma unroll
  for (int e = 0; e < 4; ++e)
#pragma unroll
    for (int g = 0; g < 4; ++g) {
      const int e0 = e * 32 + 8 * g + 4 * h;
      uint2 pk;
      pk.x = pack2(o[e][4 * g] * il, o[e][4 * g + 1] * il);
      pk.y = pack2(o[e][4 * g + 2] * il, o[e][4 * g + 3] * il);
      *(uint2*)(mix + (size_t)tok * DM + 512 + head * 128 + e0) = pk;
    }
}

DI void retU_item(const Params& P, int l, int item2) {
  char* ws = opq(P.ws);
  const int tid = otid(), lane = tid & 63, w = (tid >> 6) & 3, r = lane & 31, h = lane >> 5;
  const int item = item2 * 2 + (tid >> 8);
  const int cidx = item / 6, hd = item % 6;
  const float* scal = (const float*)(ws + OFF_SCAL) + l * 32;
  const float lf = scal[2 + hd], lb = scal[8 + hd];
  const u16* VTC = (const u16*)(ws + OFF_VTC);
  const u16* KTC = (const u16*)(ws + OFF_KTC);
  const int t0 = cidx * 128;
  f32x16 af[2], ab[2];
  zero16(af[0]); zero16(af[1]); zero16(ab[0]); zero16(ab[1]);
  const u16* vrow = VTC + (size_t)(hd * 128 + w * 32 + r) * T + t0;
  float gpf[8], gpb[8];
#pragma unroll
  for (int jj = 0; jj < 8; ++jj) { gpf[jj] = fexp2(-lf * (float)jj); gpb[jj] = fexp2(lb * (float)jj); }
#pragma unroll 1
  for (int ks = 0; ks < 8; ++ks) {
    bf16x8 a = ld8(vrow + ks * 16 + h * 8);
    float df[8], db[8];
    const float basef = fexp2(lf * (float)(127 - ks * 16 - h * 8)), baseb = fexp2(lb * (float)(ks * 16 + h * 8));
#pragma unroll
    for (int jj = 0; jj < 8; ++jj) {
      df[jj] = basef * gpf[jj];
      db[jj] = baseb * gpb[jj];
    }
#pragma unroll
    for (int nb = 0; nb < 2; ++nb) {
      uint4 raw = *(const uint4*)(KTC + (size_t)(hd * 64 + nb * 32 + r) * T + t0 + ks * 16 + h * 8);
      float kk[8] = {bflo(raw.x), bfhi(raw.x), bflo(raw.y), bfhi(raw.y), bflo(raw.z), bfhi(raw.z), bflo(raw.w), bfhi(raw.w)};
      uint4 uf, ub;
      uf.x = pack2(kk[0] * df[0], kk[1] * df[1]); uf.y = pack2(kk[2] * df[2], kk[3] * df[3]);
      uf.z = pack2(kk[4] * df[4], kk[5] * df[5]); uf.w = pack2(kk[6] * df[6], kk[7] * df[7]);
      ub.x = pack2(kk[0] * db[0], kk[1] * db[1]); ub.y = pack2(kk[2] * db[2], kk[3] * db[3]);
      ub.z = pack2(kk[4] * db[4], kk[5] * db[5]); ub.w = pack2(kk[6] * db[6], kk[7] * db[7]);
      af[nb] = MFMA32(a, __builtin_bit_cast(bf16x8, uf), af[nb]);
      ab[nb] = MFMA32(a, __builtin_bit_cast(bf16x8, ub), ab[nb]);
    }
  }
  float* U = (float*)(ws + OFF_H) + ((size_t)(cidx * 6 + hd) * 2) * 8192;
#pragma unroll
  for (int nb = 0; nb < 2; ++nb)
#pragma unroll
    for (int i = 0; i < 16; ++i) {
      const int e = w * 32 + crow(i, h), d = nb * 32 + r;
      U[e * 64 + d] = af[nb][i];
      U[8192 + e * 64 + d] = ab[nb][i];
    }
}

DI void phase_ret_scan(const Params& P, int l, int S) {
  char* ws = opq(P.ws);
  const float* scal = (const float*)(ws + OFF_SCAL) + l * 32;
  const float* U = (const float*)(ws + OFF_H);
  u16* R = (u16*)(ws + OFF_R);
  const int nseq = T / S, nc = S / 128;
  const int total = nseq * 6 * 2 * 8192;
  for (int idx = obid() * NTHR + otid(); idx < total; idx += gridDim.x * NTHR) {
    const int el = idx & 8191, dir = (idx >> 13) & 1, hd = (idx >> 14) % 6, seq = idx / (8192 * 12);
    const float gC = fexp2((dir ? scal[8 + hd] : scal[2 + hd]) * 128.f);
    float Rv = 0.f;
    for (int cc0 = 0; cc0 < nc; cc0 += 8) {
      float uv[8];
      size_t oo[8];
#pragma unroll
      for (int k = 0; k < 8; ++k) {
        const int cc = cc0 + k;
        const int ch = dir ? (nc - 1 - cc) : cc;
        oo[k] = ((size_t)((seq * nc + ch) * 6 + hd) * 2 + dir) * 8192 + el;
        uv[k] = U[oo[k]];
      }
#pragma unroll
      for (int k = 0; k < 8; ++k) {
        R[oo[k]] = f2bf(Rv);
        Rv = Rv * gC + uv[k];
      }
    }
  }
}

DI void retOut_item(const Params& P, int l, int item2) {
  char* ws = opq(P.ws);
  const int tid = otid(), lane = tid & 63, w = (tid >> 6) & 3, r = lane & 31, h = lane >> 5;
  const int item = item2 * 2 + (tid >> 8);
  const int cidx = item / 6, hd = item % 6;
  const float* scal = (const float*)(ws + OFF_SCAL) + l * 32;
  const float lf = scal[2 + hd], lb = scal[8 + hd];
  const u16* QC = (const u16*)(ws + OFF_QC);
  const u16* KC = (const u16*)(ws + OFF_KC);
  const u16* VTC = (const u16*)(ws + OFF_VTC);
  const u16* G = (const u16*)(ws + OFF_G);
  const u16* Rf = (const u16*)(ws + OFF_R) + ((size_t)(cidx * 6 + hd) * 2) * 8192;
  const u16* Rb = Rf + 8192;
  const int t0 = cidx * 128, il = w * 32 + r, tok = t0 + il;
  bf16x8 q[4], qf[4], qbk[4];
  const float sf = fexp2(lf * (float)(il + 1)), sb = fexp2(lb * (float)(128 - il));
#pragma unroll
  for (int ks = 0; ks < 4; ++ks) {
    q[ks] = ld8(QC + (size_t)tok * 384 + hd * 64 + ks * 16 + h * 8);
    qf[ks] = scale8(q[ks], sf);
    qbk[ks] = scale8(q[ks], sb);
  }
  f32x16 acc[4];
#pragma unroll
  for (int e = 0; e < 4; ++e) {
    zero16(acc[e]);
#pragma unroll
    for (int ks = 0; ks < 4; ++ks) {
      bf16x8 a = ld8(Rf + (e * 32 + r) * 64 + ks * 16 + h * 8);
      acc[e] = MFMA32(a, qf[ks], acc[e]);
      bf16x8 b = ld8(Rb + (e * 32 + r) * 64 + ks * 16 + h * 8);
      acc[e] = MFMA32(b, qbk[ks], acc[e]);
    }
  }
#pragma unroll 1
  for (int jb = 0; jb < 4; ++jb) {
    f32x16 s;
    zero16(s);
#pragma unroll
    for (int ks = 0; ks < 4; ++ks) {
      bf16x8 a = ld8(KC + (size_t)(t0 + jb * 32 + r) * 384 + hd * 64 + ks * 16 + h * 8);
      s = MFMA32(a, q[ks], s);
    }
#pragma unroll
    for (int i = 0; i < 16; ++i) {
      const int j = jb * 32 + crow(i, h);
      const float d = (float)(il - j);
      const float ex = d >= 0.f ? lf * d : -lb * d;
      s[i] *= fexp2(ex);
    }
#pragma unroll
    for (int s2 = 0; s2 < 2; ++s2) {
      bf16x8 pf = pack8(s, s2);
#pragma unroll
      for (int e = 0; e < 4; ++e) {
        const u16* vp = VTC + (size_t)(hd * 128 + e * 32 + r) * T + t0 + jb * 32 + s2 * 16 + 4 * h;
        uint2 lo = *(const uint2*)vp, hi = *(const uint2*)(vp + 8);
        uint4 u = make_uint4(lo.x, lo.y, hi.x, hi.y);
        acc[e] = MFMA32(__builtin_bit_cast(bf16x8, u), pf, acc[e]);
      }
    }
  }
  float ss = 0.f;
#pragma unroll
  for (int e = 0; e < 4; ++e)
#pragma unroll
    for (int i = 0; i < 16; ++i) ss += acc[e][i] * acc[e][i];
  ss += __shfl_xor(ss, 32);
  const float rstd = rsqrtf(ss * (1.f / 128.f) + EPS);
  const float* rn = P.ret_norm + l * 128;
  u16* mix = (u16*)(ws + OFF_H);
#pragma unroll
  for (int e = 0; e < 4; ++e)
#pragma unroll
    for (int g = 0; g < 4; ++g) {
      const int e0 = e * 32 + 8 * g + 4 * h;
      float4 gn = *(const float4*)(rn + e0);
      uint2 gt = *(const uint2*)(G + (size_t)tok * 768 + hd * 128 + e0);
      uint2 pk;
      pk.x = pack2(acc[e][4 * g] * rstd * gn.x * bflo(gt.x), acc[e][4 * g + 1] * rstd * gn.y * bfhi(gt.x));
      pk.y = pack2(acc[e][4 * g + 2] * rstd * gn.z * bflo(gt.y), acc[e][4 * g + 3] * rstd * gn.w * bfhi(gt.y));
      *(uint2*)(mix + (size_t)tok * DM + 1280 + hd * 128 + e0) = pk;
    }
}

DI uint4 conv8(const uint4& g0, const uint4& g1, const uint4& g2, const uint4& uu, const float (&cb8)[8], const float (&w0)[8],
               const float (&w1)[8], const float (&w2)[8]) {
  uint4 res;
#define CONV2(F, O) { \
    float x0 = cb8[O] + w0[O] * bflo(g0.F) + w1[O] * bflo(g1.F) + w2[O] * bflo(g2.F); \
    float x1 = cb8[O + 1] + w0[O + 1] * bfhi(g0.F) + w1[O + 1] * bfhi(g1.F) + w2[O + 1] * bfhi(g2.F); \
    res.F = pack2(silu(x0) * bflo(uu.F), silu(x1) * bfhi(uu.F)); }
  CONV2(x, 0) CONV2(y, 2) CONV2(z, 4) CONV2(w, 6)
#undef CONV2
  return res;
}

DI void phase_conv(const Params& P, int l, int posmask) {
  char* ws = opq(P.ws);
  const u16* __restrict__ GG = (const u16*)(ws + OFF_GG);
  u16* __restrict__ UU = (u16*)(ws + OFF_UU);
  const float* cw = P.conv_w + (size_t)l * 3 * DFF;
  const float* cbp = P.conv_b + (size_t)l * DFF;
  constexpr int NCG = DFF / 8, TB = 32;
  const int total = (T / TB) * NCG;
  for (int task = obid() * NTHR + otid(); task < total; task += gridDim.x * NTHR) {
    const int tb = task / NCG, c8 = (task % NCG) * 8;
    const int t0 = tb * TB;
    float cb8[8], w0[8], w1[8], w2[8];
#pragma unroll
    for (int k = 0; k < 2; ++k) {
      float4 a = *(const float4*)(cbp + c8 + 4 * k), b0 = *(const float4*)(cw + c8 + 4 * k), b1 = *(const float4*)(cw + DFF + c8 + 4 * k),
             b2 = *(const float4*)(cw + 2 * DFF + c8 + 4 * k);
      cb8[4 * k] = a.x; cb8[4 * k + 1] = a.y; cb8[4 * k + 2] = a.z; cb8[4 * k + 3] = a.w;
      w0[4 * k] = b0.x; w0[4 * k + 1] = b0.y; w0[4 * k + 2] = b0.z; w0[4 * k + 3] = b0.w;
      w1[4 * k] = b1.x; w1[4 * k + 1] = b1.y; w1[4 * k + 2] = b1.z; w1[4 * k + 3] = b1.w;
      w2[4 * k] = b2.x; w2[4 * k + 1] = b2.y; w2[4 * k + 2] = b2.z; w2[4 * k + 3] = b2.w;
    }
    const u16* gp = GG + (size_t)t0 * DFF + c8;
    u16* up = UU + (size_t)t0 * DFF + c8;
    const int s0 = t0 & posmask;
    uint4 gm = *(const uint4*)(gp - (s0 > 0 ? DFF : 0));
    {
      const unsigned k0 = (s0 > 0) ? 0xffffffffu : 0u;
      gm.x &= k0; gm.y &= k0; gm.z &= k0; gm.w &= k0;
    }
    uint4 gc = *(const uint4*)gp;
#pragma unroll 1
    for (int j = 0; j < TB; j += 4) {
      uint4 gn[4], uu[4];
#pragma unroll
      for (int k = 0; k < 4; ++k) {
        const bool last = ((s0 + j + k) == posmask);
        gn[k] = *(const uint4*)(gp + (size_t)(j + k + (last ? 0 : 1)) * DFF);
        const unsigned km = last ? 0u : 0xffffffffu;
        gn[k].x &= km; gn[k].y &= km; gn[k].z &= km; gn[k].w &= km;
        uu[k] = *(const uint4*)(up + (size_t)(j + k) * DFF);
      }
#pragma unroll
      for (int k = 0; k < 4; ++k) {
        const uint4 res = conv8(gm, gc, gn[k], uu[k], cb8, w0, w1, w2);
        *(uint4*)(up + (size_t)(j + k) * DFF) = res;
        gm = gc;
        gc = gn[k];
      }
    }
  }
}

#define XB_TMO      128
#define XB_XCNT(j)  (256  + 64 * (j))
#define XB_XSUB(j)  (1280 + 64 * (j))
#define XB_XGEN(j)  (2304 + 64 * (j))
#define XB_TOP      3328
#define XB_TOPGEN   3392
#define XCD_BAR_WORDS 3456
#define XB_SPIN_CAP (1u << 22)
#define LAS __attribute__((address_space(3)))
DI unsigned xb_ld(unsigned* p) { return __hip_atomic_load(p, __ATOMIC_RELAXED, __HIP_MEMORY_SCOPE_AGENT); }
DI unsigned xb_add(unsigned* p, unsigned v) { return __hip_atomic_fetch_add(p, v, __ATOMIC_RELAXED, __HIP_MEMORY_SCOPE_AGENT); }
DI unsigned xb_xcc_id() { return (unsigned)__builtin_amdgcn_s_getreg((3 << 11) | 20) & 0xFu; }
#define XB_SPIN(cond, bar) do { unsigned _sp = 0; while (cond) { __builtin_amdgcn_s_sleep(1); \
    if ((++_sp & 255u) == 0u) { if (xb_ld(&(bar)[XB_TMO])) break; if (_sp > XB_SPIN_CAP) { atomicAdd(&(bar)[XB_TMO], 1u); break; } } } } while (0)
struct XcdBarrier { unsigned* bar; unsigned x; volatile LAS unsigned* st; };
DI XcdBarrier xcd_barrier_post(unsigned* bar, volatile LAS unsigned* st) {
  XcdBarrier b; b.bar = bar; b.x = xb_xcc_id(); b.st = st;
  if (threadIdx.x == 0) (void)xb_add(&bar[XB_XCNT(b.x)], 1u);
  return b;
}
DI void xcd_barrier_complete(unsigned* bar, unsigned x, unsigned& nloc, unsigned& nx) {
  const unsigned G = gridDim.x * gridDim.y * gridDim.z;
  unsigned sum, cnt, mine, sp = 0u;
  for (;;) {
    sum = 0u; cnt = 0u; mine = 0u;
#pragma unroll
    for (unsigned j = 0; j < 16; ++j) { const unsigned c = xb_ld(&bar[XB_XCNT(j)]); sum += c; cnt += (c > 0u) ? 1u : 0u; mine = (j == x) ? c : mine; }
    if (sum == G) break;
    __builtin_amdgcn_s_sleep(1);
    if ((++sp & 255u) == 0u) { if (xb_ld(&bar[XB_TMO])) break; if (sp > XB_SPIN_CAP) { atomicAdd(&bar[XB_TMO], 1u); break; } }
  }
  nloc = mine > 0u ? mine : 1u; nx = cnt > 0u ? cnt : 1u;
}
template <bool FIRST>
DI void xcd_barrier(const XcdBarrier& b) {
  asm volatile("s_waitcnt vmcnt(0)" ::: "memory");
  __syncthreads();
  if (threadIdx.x == 0) {
    unsigned* bar = b.bar;
    __builtin_amdgcn_s_waitcnt(0);
    unsigned nloc = b.st[0], nx = b.st[1];
    if (FIRST) { xcd_barrier_complete(bar, b.x, nloc, nx); b.st[0] = nloc; b.st[1] = nx; }
    const unsigned old = xb_add(&bar[XB_XSUB(b.x)], 1u);
    const unsigned gen = old / nloc;
    if (old + 1u == (gen + 1u) * nloc) {
      __builtin_amdgcn_fence(__ATOMIC_RELEASE, "agent");
      asm volatile("s_waitcnt vmcnt(0)" ::: "memory");
      const unsigned og = xb_add(&bar[XB_TOP], 1u);
      const unsigned tg = og / nx;
      if (og + 1u == (tg + 1u) * nx) xb_add(&bar[XB_TOPGEN], 1u);
      else XB_SPIN(xb_ld(&bar[XB_TOPGEN]) == tg, bar);
      __builtin_amdgcn_fence(__ATOMIC_ACQUIRE, "agent");
      xb_add(&bar[XB_XGEN(b.x)], 1u);
      asm volatile("s_waitcnt vmcnt(0)" ::: "memory");
    } else {
      XB_SPIN(xb_ld(&bar[XB_XGEN(b.x)]) == gen, bar);
      __builtin_amdgcn_fence(__ATOMIC_ACQUIRE, "agent");
      asm volatile("s_waitcnt vmcnt(0)" ::: "memory");
    }
  }
  __syncthreads();
}

enum { PH_PREP = 0, PH_NORM1, PH_ZGEMM, PH_CQNORM, PH_QKV, PH_SCAN, PH_MIX, PH_COMBINE, PH_WO, PH_NORM2, PH_GU, PH_CONV, PH_DOWN, PH_FINAL, PH_COUNT };

template <int ph>
DI void run_phase(const Params& P, int l, int rq, char* smem, int* s_item, int dup = 0) {
  char* ws = opq(P.ws);
  const int S = rq == 0 ? 16384 : 2048;
  const int posmask = S - 1;
  float* xo = P.out + (size_t)rq * T * DM;
  const float* xcur = (l == 0) ? P.x_in[rq] : xo;
  switch (ph) {
    case PH_PREP:
#if !COOP
      if (l == 0) phase_rope(P);
#endif
      phase_prep(P, l, smem); break;
    case PH_NORM1: phase_rmsnorm_bf16(xcur, P.norm_mix + l * DM, (u16*)(ws + OFF_H)); break;
    case PH_ZGEMM: {
      EpiZ e;
      e.QA = (u16*)(ws + OFF_QA); e.KA = (u16*)(ws + OFF_KA); e.VTA = (u16*)(ws + OFF_VTA); e.CQ = (u16*)(ws + OFF_CQ);
      e.KB = (u16*)(ws + OFF_KB); e.QC = (u16*)(ws + OFF_QC); e.KC = (u16*)(ws + OFF_KC); e.KTC = (u16*)(ws + OFF_KTC);
      e.VTC = (u16*)(ws + OFF_VTC); e.G = (u16*)(ws + OFF_G);
      e.ropeA = (const float2*)(ws + OFF_ROPEA); e.ropeB = (const float2*)(ws + OFF_ROPEB); e.ropeC = (const float2*)(ws + OFF_ROPEC);
      e.posmask = posmask;
      gemm_phase<256, 256>((const u16*)(ws + OFF_H), DM, (const u16*)(ws + OFF_WT_IN), DM, T, INC, DM, smem, e, 0);
    } break;
    case PH_CQNORM: phase_cqnorm((u16*)(ws + OFF_CQ), P.mla_q_norm + l * 512, P.mla_kv_norm + l * 256); break;
    case PH_QKV: {
      EpiUQ e1;
      e1.QB = (u16*)(ws + OFF_QB); e1.ropeB = (const float2*)(ws + OFF_ROPEB); e1.posmask = posmask;
      gemm_phase<256, 256>((const u16*)(ws + OFF_CQ), 768, (const u16*)(ws + OFF_WT_UQ), 512, T, 1152, 512, smem, e1, 0);
      EpiUKV e2;
      e2.KB = (u16*)(ws + OFF_KB); e2.VTB = (u16*)(ws + OFF_VTB);
      const int g = gridDim.x;
      gemm_phase<256, 256>((const u16*)(ws + OFF_CQ) + 512, 768, (const u16*)(ws + OFF_WT_UKV), 256, T, 1536, 256, smem, e2,
                           g - (320 % g));
      const int sh = g - ((320 + 384) % g);
      for (int it = (obid() + sh) % g; it < 64 * 6; it += g) retU_item(P, l, it);
    } break;
    case PH_SCAN: phase_ret_scan(P, l, S); break;
    case PH_MIX: {
      int* cnt = (int*)(ws + OFF_CNT) + (l * 2 + rq) + 4 * dup;
      const int nA = (T / 256) * 8, nB = (T / 256) * 6, nR = 64 * 6;
      for (;;) {
        __syncthreads();
        if (otid() == 0) *s_item = atomicAdd(cnt, 1);
        __syncthreads();
        const int it = *s_item;
        if (it >= nA + nB + nR) break;
        if (it < nB) attnB_item(P, S, it, smem);
        else if (it < nB + nA) attnA_item(P, l, S, it - nB, smem);
        else retOut_item(P, l, it - nB - nA);
      }
    } break;
    case PH_COMBINE: phase_combine(P, l); break;
    case PH_WO: {
      EpiRes e;
      e.xin = xcur; e.out = xo;
      gemm_phase<256, 256>((const u16*)(ws + OFF_H), DM, (const u16*)(ws + OFF_WT_O), DM, T, DM, DM, smem, e, 0);
    } break;
    case PH_NORM2: phase_rmsnorm_bf16(xo, P.norm_ffn + l * DM, (u16*)(ws + OFF_H)); break;
    case PH_GU: {
      EpiGU e;
      e.GG = (u16*)(ws + OFF_GG); e.UU = (u16*)(ws + OFF_UU);
      gemm_phase<256, 256>((const u16*)(ws + OFF_H), DM, (const u16*)(ws + OFF_WT_GU), DM, T, 2 * DFF, DM, smem, e, 0);
    } break;
    case PH_CONV: phase_conv(P, l, posmask); break;
    case PH_DOWN: {
      EpiRes e;
      e.xin = xo; e.out = xo;
      gemm_phase<256, 256>((const u16*)(ws + OFF_UU), DFF, (const u16*)(ws + OFF_WT_DN), DFF, T, DM, DFF, smem, e, 0);
    } break;
    case PH_FINAL: phase_final_norm(xo, P.norm_final); break;
  }
}

#if COOP
__global__ void __launch_bounds__(NTHR, 2) mega_kernel(Params P) {
  extern __shared__ __attribute__((aligned(16))) char smem[];
  int* s_itemp = (int*)(smem + LDS_MAIN);
  uint4* xbw = (uint4*)(smem + LDS_MAIN + 16);
  cg::grid_group grid = cg::this_grid();
  if (threadIdx.x == 0) *xbw = make_uint4(0u, 0u, 0u, 0u);
  __syncthreads();
  XcdBarrier xb = xcd_barrier_post((unsigned*)(P.ws + OFF_BAR), (volatile LAS unsigned*)xbw);
#define GSYNC() xcd_barrier<false>(xb)
  phase_rope(P);
#pragma unroll 1
  for (int l = 0; l < 2; ++l) {
    run_phase<PH_PREP>(P, l, 0, smem, s_itemp);
    if (l == 0) { grid.sync(); xcd_barrier<true>(xb); } else GSYNC();
#pragma unroll 1
    for (int rq = 0; rq < 2; ++rq) {
      run_phase<PH_NORM1>(P, l, rq, smem, s_itemp);  GSYNC();
      run_phase<PH_ZGEMM>(P, l, rq, smem, s_itemp);  GSYNC();
      run_phase<PH_CQNORM>(P, l, rq, smem, s_itemp); GSYNC();
      run_phase<PH_QKV>(P, l, rq, smem, s_itemp);    GSYNC();
      run_phase<PH_SCAN>(P, l, rq, smem, s_itemp);   GSYNC();
      run_phase<PH_MIX>(P, l, rq, smem, s_itemp);    GSYNC();
      run_phase<PH_COMBINE>(P, l, rq, smem, s_itemp); GSYNC();
      run_phase<PH_WO>(P, l, rq, smem, s_itemp);     GSYNC();
      run_phase<PH_NORM2>(P, l, rq, smem, s_itemp);  GSYNC();
      run_phase<PH_GU>(P, l, rq, smem, s_itemp);     GSYNC();
      run_phase<PH_CONV>(P, l, rq, smem, s_itemp);   GSYNC();
      run_phase<PH_DOWN>(P, l, rq, smem, s_itemp);   GSYNC();
    }
  }
  run_phase<PH_FINAL>(P, 0, 0, smem, s_itemp);
  run_phase<PH_FINAL>(P, 0, 1, smem, s_itemp);
}
#else
template <int PH>
__global__ void __launch_bounds__(NTHR, 2) phase_kernel(Params P, int l, int rq) {
  extern __shared__ __attribute__((aligned(16))) char smem[];
  int* s_itemp = (int*)(smem + LDS_MAIN);
  run_phase<PH>(P, l, rq, smem, s_itemp);
}
#endif

extern "C" void kernel_launch(void* const* d_in, const int* in_sizes, int n_in, void* d_out, int out_size, void* d_ws,
                              size_t ws_size, hipStream_t stream) {
  Params P{};
  P.x_in[0] = (const float*)d_in[0];
  P.x_in[1] = (const float*)d_in[1];
  P.norm_mix = (const float*)d_in[2];
  P.w_in = (const float*)d_in[3];
  P.diff_lambda = (const float*)d_in[4];
  P.diff_norm = (const float*)d_in[5];
  P.mla_q_norm = (const float*)d_in[6];
  P.mla_kv_norm = (const float*)d_in[7];
  P.w_uq = (const float*)d_in[8];
  P.w_ukv = (const float*)d_in[9];
  P.ret_decay_fwd = (const float*)d_in[10];
  P.ret_decay_bwd = (const float*)d_in[11];
  P.ret_norm = (const float*)d_in[12];
  P.w_o = (const float*)d_in[13];
  P.norm_ffn = (const float*)d_in[14];
  P.w_gate = (const float*)d_in[15];
  P.w_up = (const float*)d_in[16];
  P.conv_w = (const float*)d_in[17];
  P.conv_b = (const float*)d_in[18];
  P.w_down = (const float*)d_in[19];
  P.norm_final = (const float*)d_in[20];
  P.out = (float*)d_out;
  P.ws = (char*)d_ws;
  if (ws_size < OFF_FFNEND || ws_size < OFF_MIXEND) {
    fprintf(stderr, "workspace too small: %zu\n", ws_size);
    return;
  }
  (void)hipMemsetAsync((char*)d_ws + OFF_CNT, 0, 4096 + 16384, stream);
#if COOP
  static int grid_blocks = 0;
  if (!grid_blocks) {
    int dev = 0, cus = 0, per_cu = 0;
    (void)hipGetDevice(&dev);
    (void)hipDeviceGetAttribute(&cus, hipDeviceAttributeMultiprocessorCount, dev);
    (void)hipFuncSetAttribute((const void*)mega_kernel, hipFuncAttributeMaxDynamicSharedMemorySize, DYN_LDS);
    (void)hipOccupancyMaxActiveBlocksPerMultiprocessor(&per_cu, mega_kernel, NTHR, DYN_LDS);
    if (per_cu > 1) per_cu = 1;
    if (per_cu < 1) per_cu = 1;
    grid_blocks = cus * per_cu;
  }
  void* args[] = {&P};
  hipError_t e = hipLaunchCooperativeKernel((const void*)mega_kernel, dim3(grid_blocks), dim3(NTHR), args, DYN_LDS, stream);
  if (e != hipSuccess) fprintf(stderr, "cooperative launch failed: %s (grid %d)\n", hipGetErrorString(e), grid_blocks);
#else
  const int grid = 256;
#define LP(PH, l, rq) do { (void)hipFuncSetAttribute((const void*)phase_kernel<PH>, hipFuncAttributeMaxDynamicSharedMemorySize, DYN_LDS); phase_kernel<PH><<<grid, NTHR, DYN_LDS, stream>>>(P, l, rq); } while (0)
  for (int l = 0; l < 2; ++l) {
    LP(PH_PREP, l, 0);
    for (int rq = 0; rq < 2; ++rq) {
      LP(PH_NORM1, l, rq); LP(PH_ZGEMM, l, rq); LP(PH_CQNORM, l, rq); LP(PH_QKV, l, rq); LP(PH_SCAN, l, rq); LP(PH_MIX, l, rq); LP(PH_COMBINE, l, rq);
      LP(PH_WO, l, rq); LP(PH_NORM2, l, rq); LP(PH_GU, l, rq); LP(PH_CONV, l, rq); LP(PH_DOWN, l, rq);
    }
  }
  LP(PH_FINAL, 0, 0);
  LP(PH_FINAL, 0, 1);
#endif
}
```

```cpp
#include <hip/hip_runtime.h>
#include <hip/hip_cooperative_groups.h>
#include <stdint.h>
#include <cstdio>
namespace cg = cooperative_groups;

#define DI __device__ __forceinline__
typedef unsigned short u16;
using bf16x8 = __attribute__((ext_vector_type(8))) short;
using f32x16 = __attribute__((ext_vector_type(16))) float;
typedef __bf16 bf2_t __attribute__((ext_vector_type(2)));
typedef float f2_t __attribute__((ext_vector_type(2)));
typedef unsigned u32x4 __attribute__((ext_vector_type(4)));
typedef unsigned u32x2 __attribute__((ext_vector_type(2)));
#define MFMA32(a, b, c) __builtin_amdgcn_mfma_f32_32x32x16_bf16((a), (b), (c), 0, 0, 0)

#ifndef COOP
#define COOP 1
#endif

constexpr int T = 16384;
constexpr int DM = 2048;
constexpr int INC = 4672;
constexpr int DFF = 5632;
constexpr float EPS = 1e-5f;
constexpr int NTHR = 512;
constexpr int NWAVE = NTHR / 64;
constexpr int LDS_MAIN = 131072;
constexpr int DYN_LDS = LDS_MAIN + 64;

constexpr size_t SZ_WT_IN = (size_t)INC * DM * 2;
constexpr size_t SZ_WT_UQ = (size_t)1152 * 512 * 2;
constexpr size_t SZ_WT_UKV = (size_t)1536 * 256 * 2;
constexpr size_t SZ_WT_O = (size_t)DM * DM * 2;
constexpr size_t SZ_WT_GU = (size_t)2 * DFF * DM * 2;
constexpr size_t SZ_WT_DN = (size_t)DM * DFF * 2;
constexpr size_t OFF_WT_IN = 0;
constexpr size_t OFF_WT_UQ = OFF_WT_IN + SZ_WT_IN;
constexpr size_t OFF_WT_UKV = OFF_WT_UQ + SZ_WT_UQ;
constexpr size_t OFF_WT_O = OFF_WT_UKV + SZ_WT_UKV;
constexpr size_t OFF_WT_GU = OFF_WT_O + SZ_WT_O;
constexpr size_t OFF_WT_DN = OFF_WT_GU + SZ_WT_GU;
constexpr size_t OFF_ROPEA = OFF_WT_DN + SZ_WT_DN;
constexpr size_t OFF_ROPEB = OFF_ROPEA + (size_t)16384 * 8 * 8;
constexpr size_t OFF_ROPEC = OFF_ROPEB + (size_t)16384 * 32 * 8;
constexpr size_t OFF_SCAL = OFF_ROPEC + (size_t)16384 * 32 * 8;
constexpr size_t OFF_CNT = OFF_SCAL + 4096;
constexpr size_t OFF_BAR = OFF_CNT + 4096;
constexpr size_t OFF_ACT = OFF_BAR + 16384;
constexpr size_t OFF_H = OFF_ACT;
constexpr size_t OFF_QA = OFF_H + (size_t)T * DM * 2;
constexpr size_t OFF_KA = OFF_QA + (size_t)T * 512 * 2;
constexpr size_t OFF_VTA = OFF_KA + (size_t)T * 512 * 2;
constexpr size_t OFF_CQ = OFF_VTA + (size_t)T * 512 * 2;
constexpr size_t OFF_QB = OFF_CQ + (size_t)T * 768 * 2;
constexpr size_t OFF_KB = OFF_QB + (size_t)T * 1152 * 2;
constexpr size_t OFF_VTB = OFF_KB + (size_t)T * 1152 * 2;
constexpr size_t OFF_QC = OFF_VTB + (size_t)T * 768 * 2;
constexpr size_t OFF_KC = OFF_QC + (size_t)T * 384 * 2;
constexpr size_t OFF_KTC = OFF_KC + (size_t)T * 384 * 2;
constexpr size_t OFF_VTC = OFF_KTC + (size_t)T * 384 * 2;
constexpr size_t OFF_G = OFF_VTC + (size_t)T * 768 * 2;
constexpr size_t OFF_R = OFF_G + (size_t)T * 768 * 2;
constexpr size_t OFF_O1 = OFF_R + (size_t)128 * 6 * 2 * 8192 * 2;
constexpr size_t OFF_MIXEND = OFF_O1 + (size_t)2 * T * 512 * 4;
constexpr size_t OFF_GG = OFF_H + (size_t)T * DM * 2;
constexpr size_t OFF_UU = OFF_GG + (size_t)T * DFF * 2;
constexpr size_t OFF_FFNEND = OFF_UU + (size_t)T * DFF * 2;

struct Params {
  const float* x_in[2];
  const float *norm_mix, *w_in, *diff_lambda, *diff_norm, *mla_q_norm, *mla_kv_norm, *w_uq, *w_ukv, *ret_decay_fwd,
      *ret_decay_bwd, *ret_norm, *w_o, *norm_ffn, *w_gate, *w_up, *conv_w, *conv_b, *w_down, *norm_final;
  float* out;
  char* ws;
};

DI unsigned pack2(float a, float b) {
  f2_t v = {a, b};
  bf2_t r = __builtin_convertvector(v, bf2_t);
  return __builtin_bit_cast(unsigned, r);
}
DI u16 f2bf(float a) { return (u16)(pack2(a, 0.f) & 0xffffu); }
DI float bf2f(u16 u) { return __uint_as_float(((unsigned)u) << 16); }
DI float bflo(unsigned u) { return __uint_as_float(u << 16); }
DI float bfhi(unsigned u) { return __uint_as_float(u & 0xffff0000u); }
DI int otid() { int t = threadIdx.x; asm volatile("" : "+v"(t)); return t; }
DI int obid() { int b = __builtin_amdgcn_readfirstlane((int)blockIdx.x); asm volatile("" : "+s"(b)); return b; }
DI char* opq(char* p) {
  unsigned z = 0;
  asm volatile("" : "+s"(z));
  return p + z;
}
DI int crow(int i, int h) { return (i & 3) + 8 * (i >> 2) + 4 * h; }
DI float wave_sum(float v) {
#pragma unroll
  for (int o = 32; o > 0; o >>= 1) v += __shfl_xor(v, o);
  return v;
}
DI float fexp2(float x) { return __builtin_amdgcn_exp2f(x); }
DI float silu(float x) { return x / (1.f + __expf(-x)); }
DI bf16x8 pack8(const f32x16& x, int s2) {
  uint4 u;
  u.x = pack2(x[8 * s2 + 0], x[8 * s2 + 1]);
  u.y = pack2(x[8 * s2 + 2], x[8 * s2 + 3]);
  u.z = pack2(x[8 * s2 + 4], x[8 * s2 + 5]);
  u.w = pack2(x[8 * s2 + 6], x[8 * s2 + 7]);
  return __builtin_bit_cast(bf16x8, u);
}
DI bf16x8 scale8(bf16x8 q, float s) {
  uint4 u = __builtin_bit_cast(uint4, q);
  u.x = pack2(bflo(u.x) * s, bfhi(u.x) * s);
  u.y = pack2(bflo(u.y) * s, bfhi(u.y) * s);
  u.z = pack2(bflo(u.z) * s, bfhi(u.z) * s);
  u.w = pack2(bflo(u.w) * s, bfhi(u.w) * s);
  return __builtin_bit_cast(bf16x8, u);
}
DI bf16x8 ld8(const u16* p) { return *(const bf16x8*)p; }
DI void zero16(f32x16& a) {
#pragma unroll
  for (int i = 0; i < 16; ++i) a[i] = 0.f;
}

DI void transpose_tile(const float* __restrict__ src, int N, u16* __restrict__ dst, int ldd, int kt, int nt, float* lds) {
  const int tid = otid();
  const int k0 = kt * 64, n0 = nt * 64;
  __syncthreads();
#pragma unroll
  for (int i = 0; i < 8; ++i) {
    int k = i * 8 + (tid >> 6), n = tid & 63;
    lds[k * 65 + n] = src[(size_t)(k0 + k) * N + n0 + n];
  }
  __syncthreads();
  {
    int n = (tid >> 3), kc = (tid & 7) * 8;
    uint4 u;
    u.x = pack2(lds[(kc + 0) * 65 + n], lds[(kc + 1) * 65 + n]);
    u.y = pack2(lds[(kc + 2) * 65 + n], lds[(kc + 3) * 65 + n]);
    u.z = pack2(lds[(kc + 4) * 65 + n], lds[(kc + 5) * 65 + n]);
    u.w = pack2(lds[(kc + 6) * 65 + n], lds[(kc + 7) * 65 + n]);
    *(uint4*)(dst + (size_t)(n0 + n) * ldd + k0 + kc) = u;
  }
}

DI void phase_rope(const Params& P) {
  char* ws = opq(P.ws);
    float2* ra = (float2*)(ws + OFF_ROPEA);
    float2* rb = (float2*)(ws + OFF_ROPEB);
    float2* rc = (float2*)(ws + OFF_ROPEC);
    const int n = 16384 * 72;
    for (int idx = obid() * NTHR + otid(); idx < n; idx += gridDim.x * NTHR) {
      int pos = idx / 72, f = idx % 72;
      double ex, th;
      float2* dst;
      if (f < 8) { ex = -(double)f / 8.0; th = 500000.0; dst = ra + pos * 8 + f; }
      else if (f < 40) { ex = -(double)(f - 8) / 32.0; th = 500000.0; dst = rb + pos * 32 + (f - 8); }
      else { ex = -(double)(f - 40) / 32.0; th = 10000.0; dst = rc + pos * 32 + (f - 40); }
      float inv = (float)exp2(ex * log2(th));
      float ang = (float)pos * inv;
      double rev = (double)ang * 0.15915494309189535;
      rev -= rint(rev);
      float a = (float)(rev * 6.283185307179586);
      *dst = make_float2(cosf(a), sinf(a));
    }
  }

DI void phase_prep(const Params& P, int l, char* smem) {
  float* lds = (float*)smem;
  char* ws = opq(P.ws);
  const int n_in = 32 * 73, n_uq = 8 * 18, n_ukv = 4 * 24, n_o = 32 * 32, n_g = 32 * 88, n_d = 88 * 32;
  const int total = n_in + n_uq + n_ukv + n_o + 2 * n_g + n_d;
  for (int t = obid(); t < total; t += gridDim.x) {
    int i = t;
    if (i < n_in) { transpose_tile(P.w_in + (size_t)l * DM * INC, INC, (u16*)(ws + OFF_WT_IN), DM, i / 73, i % 73, lds); continue; }
    i -= n_in;
    if (i < n_uq) { transpose_tile(P.w_uq + (size_t)l * 512 * 1152, 1152, (u16*)(ws + OFF_WT_UQ), 512, i / 18, i % 18, lds); continue; }
    i -= n_uq;
    if (i < n_ukv) { transpose_tile(P.w_ukv + (size_t)l * 256 * 1536, 1536, (u16*)(ws + OFF_WT_UKV), 256, i / 24, i % 24, lds); continue; }
    i -= n_ukv;
    if (i < n_o) { transpose_tile(P.w_o + (size_t)l * DM * DM, DM, (u16*)(ws + OFF_WT_O), DM, i / 32, i % 32, lds); continue; }
    i -= n_o;
    if (i < n_g) { transpose_tile(P.w_gate + (size_t)l * DM * DFF, DFF, (u16*)(ws + OFF_WT_GU), DM, i / 88, i % 88, lds); continue; }
    i -= n_g;
    if (i < n_g) { transpose_tile(P.w_up + (size_t)l * DM * DFF, DFF, (u16*)(ws + OFF_WT_GU) + (size_t)DFF * DM, DM, i / 88, i % 88, lds); continue; }
    i -= n_g;
    transpose_tile(P.w_down + (size_t)l * DFF * DM, DM, (u16*)(ws + OFF_WT_DN), DFF, i / 32, i % 32, lds);
  }
  if (obid() == 0) {
    float* scal = (float*)(ws + OFF_SCAL) + l * 32;
    const int tid = otid();
    if (tid < 64) {
      const float* lp = P.diff_lambda + (size_t)l * 256;
      float a = lp[tid] * lp[64 + tid];
      float b = lp[128 + tid] * lp[192 + tid];
      a = wave_sum(a);
      b = wave_sum(b);
      if (tid == 0) {
        float lam_init = 0.8f - 0.6f * expf(-0.3f * (float)l);
        scal[0] = expf(a) - expf(b) + lam_init;
        scal[1] = 1.0f - lam_init;
      }
      if (tid < 6) {
        float xf = P.ret_decay_fwd[l * 6 + tid], xb = P.ret_decay_bwd[l * 6 + tid];
        scal[2 + tid] = -log1pf(expf(-xf)) * 1.4426950408889634f;
        scal[8 + tid] = -log1pf(expf(-xb)) * 1.4426950408889634f;
      }
    }
  }
}

DI void phase_rmsnorm_bf16(const float* __restrict__ x, const float* __restrict__ g, u16* __restrict__ h) {
  const int lane = otid() & 63, w = otid() >> 6;
  for (int row = obid() * NWAVE + w; row < T; row += gridDim.x * NWAVE) {
    const float4* xr = (const float4*)(x + (size_t)row * DM);
    float4 v[8];
    float ss = 0.f;
#pragma unroll
    for (int i = 0; i < 8; ++i) {
      v[i] = xr[lane + 64 * i];
      ss += v[i].x * v[i].x + v[i].y * v[i].y + v[i].z * v[i].z + v[i].w * v[i].w;
    }
    ss = wave_sum(ss);
    const float rstd = rsqrtf(ss * (1.f / DM) + EPS);
#pragma unroll
    for (int i = 0; i < 8; ++i) {
      float4 g4 = ((const float4*)g)[lane + 64 * i];
      uint2 o;
      o.x = pack2(v[i].x * rstd * g4.x, v[i].y * rstd * g4.y);
      o.y = pack2(v[i].z * rstd * g4.z, v[i].w * rstd * g4.w);
      *(uint2*)(h + (size_t)row * DM + (lane + 64 * i) * 4) = o;
    }
  }
}

DI void phase_final_norm(float* __restrict__ x, const float* __restrict__ g) {
  const int lane = otid() & 63, w = otid() >> 6;
  for (int row = obid() * NWAVE + w; row < T; row += gridDim.x * NWAVE) {
    float4* xr = (float4*)(x + (size_t)row * DM);
    float4 v[8];
    float ss = 0.f;
#pragma unroll
    for (int i = 0; i < 8; ++i) {
      v[i] = xr[lane + 64 * i];
      ss += v[i].x * v[i].x + v[i].y * v[i].y + v[i].z * v[i].z + v[i].w * v[i].w;
    }
    ss = wave_sum(ss);
    const float rstd = rsqrtf(ss * (1.f / DM) + EPS);
#pragma unroll
    for (int i = 0; i < 8; ++i) {
      float4 g4 = ((const float4*)g)[lane + 64 * i];
      float4 o = make_float4(v[i].x * rstd * g4.x, v[i].y * rstd * g4.y, v[i].z * rstd * g4.z, v[i].w * rstd * g4.w);
      xr[lane + 64 * i] = o;
    }
  }
}

DI void phase_cqnorm(u16* __restrict__ cq, const float* __restrict__ gq, const float* __restrict__ gkv) {
  const int lane = otid() & 63, w = otid() >> 6;
  for (int row = obid() * NWAVE + w; row < T; row += gridDim.x * NWAVE) {
    u16* p = cq + (size_t)row * 768;
    uint4 a = *(const uint4*)(p + lane * 8);
    uint2 b = *(const uint2*)(p + 512 + lane * 4);
    float qa[8] = {bflo(a.x), bfhi(a.x), bflo(a.y), bfhi(a.y), bflo(a.z), bfhi(a.z), bflo(a.w), bfhi(a.w)};
    float kb[4] = {bflo(b.x), bfhi(b.x), bflo(b.y), bfhi(b.y)};
    float s1 = 0.f, s2 = 0.f;
#pragma unroll
    for (int i = 0; i < 8; ++i) s1 += qa[i] * qa[i];
#pragma unroll
    for (int i = 0; i < 4; ++i) s2 += kb[i] * kb[i];
    s1 = wave_sum(s1);
    s2 = wave_sum(s2);
    const float r1 = rsqrtf(s1 * (1.f / 512.f) + EPS), r2 = rsqrtf(s2 * (1.f / 256.f) + EPS);
    float4 g0 = ((const float4*)gq)[lane * 2], g1 = ((const float4*)gq)[lane * 2 + 1], g2 = ((const float4*)gkv)[lane];
    uint4 oa;
    oa.x = pack2(qa[0] * r1 * g0.x, qa[1] * r1 * g0.y);
    oa.y = pack2(qa[2] * r1 * g0.z, qa[3] * r1 * g0.w);
    oa.z = pack2(qa[4] * r1 * g1.x, qa[5] * r1 * g1.y);
    oa.w = pack2(qa[6] * r1 * g1.z, qa[7] * r1 * g1.w);
    uint2 ob;
    ob.x = pack2(kb[0] * r2 * g2.x, kb[1] * r2 * g2.y);
    ob.y = pack2(kb[2] * r2 * g2.z, kb[3] * r2 * g2.w);
    *(uint4*)(p + lane * 8) = oa;
    *(uint2*)(p + 512 + lane * 4) = ob;
  }
}

DI void store_T(u16* __restrict__ base, int col, int rb, int h, const f32x16& v) {
#pragma unroll
  for (int g = 0; g < 4; ++g) {
    uint2 pk;
    pk.x = pack2(v[4 * g], v[4 * g + 1]);
    pk.y = pack2(v[4 * g + 2], v[4 * g + 3]);
    *(uint2*)(base + (size_t)col * T + rb + 8 * g + 4 * h) = pk;
  }
}

struct EpiZ {
  u16 *QA, *KA, *VTA, *CQ, *KB, *QC, *KC, *KTC, *VTC, *G;
  const float2 *ropeA, *ropeB, *ropeC;
  int posmask;
  DI void operator()(int rb, int c64, const f32x16& v0, const f32x16& v1) const {
    if (c64 >= INC) return;
    const int lane = otid() & 63, r = lane & 31, h = lane >> 5;
    if (c64 < 1024) {
      u16* dst = (c64 < 512) ? QA : KA;
      const int cc = c64 & 511;
#pragma unroll
      for (int i = 0; i < 16; ++i) {
        const int t = rb + crow(i, h);
        float x = v0[i];
        float ot = __shfl_xor(x, 8);
        if (r < 16) {
          float2 cs = ropeA[(t & posmask) * 8 + (r & 7)];
          x = (r < 8) ? (x * cs.x - ot * cs.y) : (x * cs.x + ot * cs.y);
        }
        dst[(size_t)t * 512 + cc + r] = f2bf(x);
        dst[(size_t)t * 512 + cc + 32 + r] = f2bf(v1[i]);
      }
    } else if (c64 < 1536) {
      store_T(VTA, c64 - 1024 + r, rb, h, v0);
      store_T(VTA, c64 - 1024 + 32 + r, rb, h, v1);
    } else if (c64 < 2304) {
      const int cc = c64 - 1536;
#pragma unroll
      for (int i = 0; i < 16; ++i) {
        const int t = rb + crow(i, h);
        CQ[(size_t)t * 768 + cc + r] = f2bf(v0[i]);
        CQ[(size_t)t * 768 + cc + 32 + r] = f2bf(v1[i]);
      }
    } else if (c64 < 2368) {
#pragma unroll
      for (int i = 0; i < 16; ++i) {
        const int t = rb + crow(i, h);
        float2 cs = ropeB[(t & posmask) * 32 + r];
        u16 o0 = f2bf(v0[i] * cs.x - v1[i] * cs.y), o1 = f2bf(v1[i] * cs.x + v0[i] * cs.y);
#pragma unroll
        for (int hh = 0; hh < 6; ++hh) {
          KB[(size_t)t * 1152 + hh * 192 + 128 + r] = o0;
          KB[(size_t)t * 1152 + hh * 192 + 160 + r] = o1;
        }
      }
    } else if (c64 < 2752) {
      const int cc = c64 - 2368;
#pragma unroll
      for (int i = 0; i < 16; ++i) {
        const int t = rb + crow(i, h);
        float2 cs = ropeC[(t & posmask) * 32 + r];
        QC[(size_t)t * 384 + cc + r] = f2bf(v0[i] * cs.x - v1[i] * cs.y);
        QC[(size_t)t * 384 + cc + 32 + r] = f2bf(v1[i] * cs.x + v0[i] * cs.y);
      }
    } else if (c64 < 3136) {
      const int cc = c64 - 2752;
      f32x16 o0, o1;
#pragma unroll
      for (int i = 0; i < 16; ++i) {
        const int t = rb + crow(i, h);
        float2 cs = ropeC[(t & posmask) * 32 + r];
        o0[i] = (v0[i] * cs.x - v1[i] * cs.y) * 0.125f;
        o1[i] = (v1[i] * cs.x + v0[i] * cs.y) * 0.125f;
        KC[(size_t)t * 384 + cc + r] = f2bf(o0[i]);
        KC[(size_t)t * 384 + cc + 32 + r] = f2bf(o1[i]);
      }
      store_T(KTC, cc + r, rb, h, o0);
      store_T(KTC, cc + 32 + r, rb, h, o1);
    } else if (c64 < 3904) {
      store_T(VTC, c64 - 3136 + r, rb, h, v0);
      store_T(VTC, c64 - 3136 + 32 + r, rb, h, v1);
    } else {
      const int cc = c64 - 3904;
#pragma unroll
      for (int i = 0; i < 16; ++i) {
        const int t = rb + crow(i, h);
        G[(size_t)t * 768 + cc + r] = f2bf(silu(v0[i]));
        G[(size_t)t * 768 + cc + 32 + r] = f2bf(silu(v1[i]));
      }
    }
  }
};

struct EpiUQ {
  u16* QB;
  const float2* ropeB;
  int posmask;
  DI void operator()(int rb, int c64, const f32x16& v0, const f32x16& v1) const {
    const int lane = otid() & 63, r = lane & 31, h = lane >> 5;
    const bool isrope = ((c64 >> 6) % 3) == 2;
#pragma unroll
    for (int i = 0; i < 16; ++i) {
      const int t = rb + crow(i, h);
      float a = v0[i], b = v1[i];
      if (isrope) {
        float2 cs = ropeB[(t & posmask) * 32 + r];
        float na = a * cs.x - b * cs.y, nb = b * cs.x + a * cs.y;
        a = na; b = nb;
      }
      QB[(size_t)t * 1152 + c64 + r] = f2bf(a);
      QB[(size_t)t * 1152 + c64 + 32 + r] = f2bf(b);
    }
  }
};

struct EpiUKV {
  u16 *KB, *VTB;
  DI void operator()(int rb, int c64, const f32x16& v0, const f32x16& v1) const {
    const int lane = otid() & 63, r = lane & 31, h = lane >> 5;
    const int g = c64 >> 6, head = g >> 2, part = g & 3;
    if (part < 2) {
#pragma unroll
      for (int i = 0; i < 16; ++i) {
        const int t = rb + crow(i, h);
        KB[(size_t)t * 1152 + head * 192 + part * 64 + r] = f2bf(v0[i]);
        KB[(size_t)t * 1152 + head * 192 + part * 64 + 32 + r] = f2bf(v1[i]);
      }
    } else {
      const int e = head * 128 + (part - 2) * 64 + r;
      store_T(VTB, e, rb, h, v0);
      store_T(VTB, e + 32, rb, h, v1);
    }
  }
};

struct EpiRes {
  const float* xin;
  float* out;
  DI void operator()(int rb, int c64, const f32x16& v0, const f32x16& v1) const {
    const int lane = otid() & 63, r = lane & 31, h = lane >> 5;
    const size_t o0 = (size_t)(rb + 4 * h) * DM + c64 + r;
    float a0[16], a1[16];
#pragma unroll
    for (int i = 0; i < 16; ++i) {
      const size_t o = o0 + (size_t)((i & 3) + 8 * (i >> 2)) * DM;
      a0[i] = xin[o];
      a1[i] = xin[o + 32];
    }
#pragma unroll
    for (int i = 0; i < 16; ++i) {
      const size_t o = o0 + (size_t)((i & 3) + 8 * (i >> 2)) * DM;
      out[o] = a0[i] + v0[i];
      out[o + 32] = a1[i] + v1[i];
    }
  }
};

struct EpiGU {
  u16 *GG, *UU;
  DI void operator()(int rb, int c64, const f32x16& v0, const f32x16& v1) const {
    const int lane = otid() & 63, r = lane & 31, h = lane >> 5;
    u16* dst = (c64 < DFF) ? GG : UU;
    const int cc = (c64 < DFF) ? c64 : c64 - DFF;
#pragma unroll
    for (int i = 0; i < 16; ++i) {
      const size_t o = (size_t)(rb + crow(i, h)) * DFF + cc + r;
      dst[o] = f2bf(v0[i]);
      dst[o + 32] = f2bf(v1[i]);
    }
  }
};

template <int BM, int BN, class Epi>
DI void gemm_phase(const u16* __restrict__ A, int lda, const u16* __restrict__ Bt, int ldb, int M, int N, int K,
                   char* smem, const Epi& epi, int shift) {
  constexpr int WM = BM / 2, WN = BN / 4, MI = WM / 32, NI = WN / 32;
  constexpr int A_BYTES = BM * 128, B_BYTES = BN * 128, STAGE = A_BYTES + B_BYTES;
  constexpr int NGA = BM / (8 * NWAVE), NGB = BN / (8 * NWAVE);
  static_assert(2 * STAGE <= 131072, "lds");
  static_assert((NGA % 2) == 0 && (NGB % 2) == 0, "piece parity");
  const int tid = otid(), lane = tid & 63, r = lane & 31, h = lane >> 5;
  const int wv = __builtin_amdgcn_readfirstlane(tid >> 6);
  const int wm = wv >> 2, wn = wv & 3;
  const int mtiles = M / BM, ntiles = (N + BN - 1) / BN, total = mtiles * ntiles;
  const int nk = K / 64;
  const int grid = gridDim.x;
  const int vb = (obid() + shift) % grid;
  const int ntl = (vb < total) ? (total - vb + grid - 1) / grid : 0;
  const int nIter = ntl * nk;
  const int cE = (lane & 7) ^ ((lane >> 4) & 7), cO = (lane & 7) ^ (((lane >> 4) + 4) & 7);
  const unsigned offAE = (unsigned)((lane >> 3) * lda + cE * 8) * 2u, offAO = (unsigned)((lane >> 3) * lda + cO * 8) * 2u;
  const unsigned offBE = (unsigned)((lane >> 3) * ldb + cE * 8) * 2u, offBO = (unsigned)((lane >> 3) * ldb + cO * 8) * 2u;
  const int sw = (r >> 1) & 7;
  unsigned fo[4];
#pragma unroll
  for (int ks = 0; ks < 4; ++ks) fo[ks] = (unsigned)(r * 128 + (((ks * 2 + h) ^ sw) * 16));

  int p_t = 0, p_k = 0, p_it = 0;
  auto issue = [&]() {
    const int tile = vb + p_t * grid;
    const int sup = tile / (32 * ntiles), rem = tile % (32 * ntiles);
    const int nt = rem / 32, mt = sup * 32 + (rem % 32);
    const int m0 = mt * BM, n0 = nt * BN;
    char* st = smem + (p_it & 1) * STAGE;
#pragma unroll
    for (int i = 0; i < NGA; ++i) {
      const int rowb = m0 + (wv * NGA + i) * 8;
      const char* g = (const char*)(A + (size_t)rowb * lda + p_k * 64) + ((i & 1) ? offAO : offAE);
      __builtin_amdgcn_global_load_lds((const unsigned*)g, (__attribute__((address_space(3))) unsigned*)(st + (wv * NGA + i) * 1024), 16, 0, 0);
    }
#pragma unroll
    for (int i = 0; i < NGB; ++i) {
      int rowb = n0 + (wv * NGB + i) * 8;
      rowb = rowb <= N - 8 ? rowb : N - 8;
      const char* g = (const char*)(Bt + (size_t)rowb * ldb + p_k * 64) + ((i & 1) ? offBO : offBE);
      __builtin_amdgcn_global_load_lds((const unsigned*)g, (__attribute__((address_space(3))) unsigned*)(st + A_BYTES + (wv * NGB + i) * 1024), 16, 0, 0);
    }
    ++p_it;
    if (++p_k == nk) { p_k = 0; ++p_t; }
  };

  f32x16 acc[MI][NI];
#pragma unroll
  for (int i = 0; i < MI; ++i)
#pragma unroll
    for (int j = 0; j < NI; ++j) zero16(acc[i][j]);

  asm volatile("s_waitcnt vmcnt(0)" ::: "memory");
  __syncthreads();
  bf16x8 fa[2][MI], fb[2][NI];
#define GEMM_LDFRAG(set_, base_, ks_) { const char* As_ = (base_) + (wm * WM) * 128; const char* Bs_ = (base_) + A_BYTES + (wn * WN) * 128; \
    _Pragma("unroll") for (int j = 0; j < NI; ++j) fb[set_][j] = *(const bf16x8*)(Bs_ + j * 4096 + fo[ks_]); \
    _Pragma("unroll") for (int i = 0; i < MI; ++i) fa[set_][i] = *(const bf16x8*)(As_ + i * 4096 + fo[ks_]); }
#define GEMM_MMA(set_) { __builtin_amdgcn_sched_barrier(0); __builtin_amdgcn_s_setprio(1); \
    _Pragma("unroll") for (int i = 0; i < MI; ++i) _Pragma("unroll") for (int j = 0; j < NI; ++j) acc[i][j] = MFMA32(fa[set_][i], fb[set_][j], acc[i][j]); \
    __builtin_amdgcn_s_setprio(0); __builtin_amdgcn_sched_barrier(0); \
    __builtin_amdgcn_s_waitcnt(0xC07F);   \
    __builtin_amdgcn_sched_barrier(0); }
  if (nIter > 0) issue();
  if (nIter > 1) issue();
  if (nIter > 0) {
    if (nIter > 1) asm volatile("s_waitcnt vmcnt(%0)" ::"n"(NGA + NGB) : "memory");
    else asm volatile("s_waitcnt vmcnt(0)" ::: "memory");
    __builtin_amdgcn_s_barrier();
    GEMM_LDFRAG(0, smem, 0);
  }
  __builtin_amdgcn_s_waitcnt(0xC07F);
  int c_t = 0, c_k = 0;
  for (int it = 0; it < nIter; ++it) {
    const char* base = smem + (it & 1) * STAGE;
    GEMM_LDFRAG(1, base, 1);
    GEMM_MMA(0);
    GEMM_LDFRAG(0, base, 2);
    GEMM_MMA(1);
    GEMM_LDFRAG(1, base, 3);
    GEMM_MMA(0);
    __builtin_amdgcn_s_waitcnt(0xC07F);
    asm volatile("s_waitcnt vmcnt(0)" ::: "memory");
    __builtin_amdgcn_s_barrier();
    if (it + 2 < nIter) issue();
    if (it + 1 < nIter) { GEMM_LDFRAG(0, smem + ((it + 1) & 1) * STAGE, 0); }
    GEMM_MMA(1);
    __builtin_amdgcn_s_waitcnt(0xC07F);
    if (++c_k == nk) {
      c_k = 0;
      const int tile = vb + c_t * grid;
      ++c_t;
      const int sup = tile / (32 * ntiles), rem = tile % (32 * ntiles);
      const int nt = rem / 32, mt = sup * 32 + (rem % 32);
      const int m0 = mt * BM, n0 = nt * BN;
#pragma unroll
      for (int i = 0; i < MI; ++i)
#pragma unroll
        for (int j = 0; j < NI; j += 2) {
          if (n0 + wn * WN + j * 32 < N) epi(m0 + wm * WM + i * 32, n0 + wn * WN + j * 32, acc[i][j], acc[i][j + 1]);
          zero16(acc[i][j]);
          zero16(acc[i][j + 1]);
        }
    }
  }
#undef GEMM_LDFRAG
#undef GEMM_MMA
  __syncthreads();
}

template <int DK, int NB>
DI void attn_ldk(const u16* __restrict__ Ks, int ks0, int pr, int h, bf16x8 (&kf)[2 * NB]) {
  constexpr int LDKK = DK + 8;
#pragma unroll
  for (int j = 0; j < NB; ++j)
#pragma unroll
    for (int kb = 0; kb < 2; ++kb) kf[j * 2 + kb] = ld8(Ks + (kb * 32 + pr) * LDKK + (ks0 + j) * 16 + h * 8);
}
template <int DK, int NB>
DI void attn_mmaqk(const bf16x8 (&kf)[2 * NB], const bf16x8 (&qf)[DK / 16], int ks0, f32x16 (&s)[2]) {
  __builtin_amdgcn_sched_barrier(0);
#pragma unroll
  for (int j = 0; j < NB; ++j)
#pragma unroll
    for (int kb = 0; kb < 2; ++kb) s[kb] = MFMA32(kf[j * 2 + kb], qf[ks0 + j], s[kb]);
  __builtin_amdgcn_sched_barrier(0);
}
template <int DK>
DI void attn_qk_full(const u16* __restrict__ Ks, const bf16x8 (&qf)[DK / 16], int pr, int h, f32x16 (&s)[2]) {
  constexpr int KS = DK / 16, NB = 2, NBATCH = KS / NB;
  bf16x8 kf[2][2 * NB];
  attn_ldk<DK, NB>(Ks, 0, pr, h, kf[0]);
#pragma unroll
  for (int b = 0; b < NBATCH; ++b) {
    if (b + 1 < NBATCH) attn_ldk<DK, NB>(Ks, (b + 1) * NB, pr, h, kf[(b + 1) & 1]);
    attn_mmaqk<DK, NB>(kf[b & 1], qf, b * NB, s);
  }
}
DI float attn_exp(f32x16& s, float c, float m, bf16x8& p0, bf16x8& p1) {
  float ps = 0.f;
#pragma unroll
  for (int i = 0; i < 16; ++i) {
    float p = fexp2(fmaf(s[i], c, -m));
    s[i] = p;
    ps += p;
  }
  p0 = pack8(s, 0);
  p1 = pack8(s, 1);
  return ps;
}
DI void attn_ldv(const u16* __restrict__ Vs, int kb, int r, int h, bf16x8 (&vf)[8]) {
#pragma unroll
  for (int s2 = 0; s2 < 2; ++s2)
#pragma unroll
    for (int e = 0; e < 4; ++e) vf[s2 * 4 + e] = ld8(Vs + (e * 32 + r) * 72 + (kb * 2 + s2) * 16 + h * 8);
}
DI void attn_mmapv(const bf16x8 (&vf)[8], const bf16x8& p0, const bf16x8& p1, f32x16 (&o)[4]) {
  __builtin_amdgcn_sched_barrier(0);
#pragma unroll
  for (int e = 0; e < 4; ++e) o[e] = MFMA32(vf[e], p0, o[e]);
#pragma unroll
  for (int e = 0; e < 4; ++e) o[e] = MFMA32(vf[4 + e], p1, o[e]);
  __builtin_amdgcn_sched_barrier(0);
}

template <int DK>
DI void attn_pass(const u16* __restrict__ Qp, const u16* __restrict__ Kp, int ldk, const u16* __restrict__ Vt, int ntiles,
                  float c, char* smem, f32x16 (&o)[4], float& l_out) {
  constexpr bool PIPE = (DK == 64);
  constexpr int KS = DK / 16, LDKK = DK + 8, NKC = DK / 64;
  constexpr int KSTG = 64 * LDKK, VSTG = 128 * 72;
  static_assert((3 * KSTG + 2 * VSTG) * 2 <= LDS_MAIN, "lds");
  const int tid = otid(), lane = tid & 63, r = lane & 31, h = lane >> 5;
  const int pr = (r & 19) | ((r & 4) << 1) | ((r & 8) >> 1);
  bf16x8 qf[KS];
#pragma unroll
  for (int ks = 0; ks < KS; ++ks) qf[ks] = ld8(Qp + ks * 16 + h * 8);
  u16* Kl = (u16*)smem;
  u16* Vl = Kl + 3 * KSTG;
  const u16* kg = Kp + (size_t)(tid >> 3) * ldk + (tid & 7) * 8;
  const u16* vg = Vt + (size_t)(tid >> 2) * T + (tid & 3) * 16;
  const int klo = (tid >> 3) * LDKK + (tid & 7) * 8;
  const int vlo = (tid >> 2) * 72 + (tid & 3) * 16;
  constexpr int NSET = (DK == 64) ? 2 : 1;
  u32x4 kreg[NSET][NKC], vreg[NSET][2];
#define ATT_GLOADK(set_, tile_) { const int tn_ = (tile_) < ntiles ? (tile_) : ntiles - 1; const u16* kg2_ = kg + (size_t)tn_ * 64 * ldk; \
    _Pragma("unroll") for (int i = 0; i < NKC; ++i) kreg[set_][i] = *(const u32x4*)(kg2_ + i * 64); }
#define ATT_GLOADV(set_, tile_) { const int tn_ = (tile_) < ntiles ? (tile_) : ntiles - 1; const u16* vg2_ = vg + tn_ * 64; \
    _Pragma("unroll") for (int i = 0; i < 2; ++i) vreg[set_][i] = *(const u32x4*)(vg2_ + i * 8); }
#define ATT_WRITEK(set_, st_) { u16* sb_ = Kl + (st_) * KSTG + klo; _Pragma("unroll") for (int i = 0; i < NKC; ++i) *(u32x4*)(sb_ + i * 64) = kreg[set_][i]; }
#define ATT_WRITEV(set_, st_) { u16* sb_ = Vl + (st_) * VSTG + vlo; _Pragma("unroll") for (int i = 0; i < 2; ++i) *(u32x4*)(sb_ + i * 8) = vreg[set_][i]; }
  float m = -1e30f, l = 0.f;
#pragma unroll
  for (int e = 0; e < 4; ++e) zero16(o[e]);
  __syncthreads();
  if constexpr (NSET == 2) {
    ATT_GLOADK(0, 0); ATT_GLOADV(0, 0); ATT_GLOADK(1, 1);
    ATT_WRITEK(0, 0); ATT_WRITEV(0, 0); ATT_WRITEK(1, 1);
    ATT_GLOADK(0, 2); ATT_GLOADK(1, 3); ATT_GLOADV(0, 1); ATT_GLOADV(1, 2);
  } else {
    ATT_GLOADK(0, 0); ATT_GLOADV(0, 0);
    ATT_WRITEK(0, 0); ATT_WRITEV(0, 0);
    ATT_GLOADK(0, 1);
    ATT_WRITEK(0, 1);
    ATT_GLOADK(0, 2); ATT_GLOADV(0, 1);
  }
  __syncthreads();
  f32x16 s[2], sn[2];
  if constexpr (PIPE) {
    zero16(s[0]); zero16(s[1]);
    attn_qk_full<DK>(Kl, qf, pr, h, s);
  }
  int kst0 = 0, kst1 = 1, kst2 = 2;
#define ATT_TILE(SET_, tile_) { \
    ATT_WRITEK((SET_) % NSET, kst2); \
    ATT_WRITEV((SET_) % NSET, ((tile_) + 1) & 1); \
    ATT_GLOADK((SET_) % NSET, (tile_) + 2 + NSET); ATT_GLOADV((SET_) % NSET, (tile_) + 1 + NSET); \
    __builtin_amdgcn_sched_barrier(0); \
    const u16* Vs = Vl + ((tile_) & 1) * VSTG; \
    bf16x8 kfp[8]; \
    if constexpr (PIPE) attn_ldk<DK, 4>(Kl + kst1 * KSTG, 0, pr, h, kfp);     \
    if constexpr (!PIPE) { \
      zero16(s[0]); zero16(s[1]); \
      attn_qk_full<DK>(Kl + kst0 * KSTG, qf, pr, h, s); \
    } \
    bf16x8 vf[8]; \
    if constexpr (!PIPE) attn_ldv(Vs, 0, r, h, vf);                         \
    __builtin_amdgcn_sched_barrier(0); \
    float mx = -1e30f; \
    _Pragma("unroll") for (int kb = 0; kb < 2; ++kb) _Pragma("unroll") for (int i = 0; i < 16; ++i) mx = fmaxf(mx, s[kb][i]); \
    mx = fmaxf(mx, __shfl_xor(mx, 32)); \
    float mn = fmaxf(m, mx * c); \
    const bool need = __builtin_amdgcn_readfirstlane(__ballot(mn - m > 6.0f) != 0ull); \
    if (need) { \
      const float alpha = fexp2(m - mn); \
      m = mn; \
      l *= alpha; \
      _Pragma("unroll") for (int e = 0; e < 4; ++e) _Pragma("unroll") for (int i = 0; i < 16; ++i) o[e][i] *= alpha; \
    } \
    bf16x8 p0, p1; \
    if constexpr (PIPE) { \
      zero16(sn[0]); zero16(sn[1]); \
      attn_mmaqk<DK, 4>(kfp, qf, 0, sn); \
      attn_ldv(Vs, 0, r, h, vf);                                             \
      __builtin_amdgcn_sched_barrier(0); \
    } \
    float ps = attn_exp(s[0], c, m, p0, p1); \
    attn_mmapv(vf, p0, p1, o); \
    attn_ldv(Vs, 1, r, h, vf);                                               \
    __builtin_amdgcn_sched_barrier(0); \
    ps += attn_exp(s[1], c, m, p0, p1); \
    attn_mmapv(vf, p0, p1, o); \
    ps += __shfl_xor(ps, 32); \
    l += ps; \
    __syncthreads(); \
    if constexpr (PIPE) { s[0] = sn[0]; s[1] = sn[1]; } \
    kst0 = kst1; \
    kst1 = kst2; \
    kst2 = (kst1 + 1) % 3; }
  for (int tile = 0; tile < ntiles; tile += 2) {
    ATT_TILE(0, tile)
    ATT_TILE(1, tile + 1)
  }
#undef ATT_TILE
#undef ATT_GLOADK
#undef ATT_GLOADV
#undef ATT_WRITEK
#undef ATT_WRITEV
  l_out = l;
}

DI void attnA_item(const Params& P, int l, int S, int item, char* smem) {
  char* ws = opq(P.ws);
  const int nqb = S / 256;
  const int qb = item % nqb, hm = (item / nqb) % 8, seq = item / (nqb * 8);
  const int head = hm >> 1, map = hm & 1;
  const int tid = otid(), lane = tid & 63, w = tid >> 6, r = lane & 31, h = lane >> 5;
  const int q0 = seq * S + qb * 256, kv0 = seq * S;
  const u16* QA = (const u16*)(ws + OFF_QA);
  const u16* KA = (const u16*)(ws + OFF_KA);
  const u16* VTA = (const u16*)(ws + OFF_VTA);
  const int tok = q0 + w * 32 + r;
  const float c = 0.125f * 1.4426950408889634f;
  float* os = (float*)(ws + OFF_O1) + (size_t)map * T * 512 + (size_t)tok * 512 + head * 128;
  f32x16 o1[4];
  float l1;
  attn_pass<64>(QA + (size_t)tok * 512 + head * 128 + map * 64, KA + (size_t)kv0 * 512 + head * 128 + map * 64, 512,
                VTA + (size_t)(head * 128) * T + kv0, S / 64, c, smem, o1, l1);
  const float i1 = 1.f / l1;
#pragma unroll
  for (int e = 0; e < 4; ++e)
#pragma unroll
    for (int g = 0; g < 4; ++g) {
      const int e0 = e * 32 + 8 * g + 4 * h;
      *(float4*)(os + e0) = make_float4(o1[e][4 * g] * i1, o1[e][4 * g + 1] * i1, o1[e][4 * g + 2] * i1, o1[e][4 * g + 3] * i1);
    }
}

DI void phase_combine(const Params& P, int l) {
  char* ws = opq(P.ws);
  const float* scal = (const float*)(ws + OFF_SCAL) + l * 32;
  const float lam = scal[0], oml = scal[1];
  const float* O1 = (const float*)(ws + OFF_O1);
  const float* O2 = O1 + (size_t)T * 512;
  u16* mix = (u16*)(ws + OFF_H);
  const float* dn = P.diff_norm + l * 128;
  const int lane = otid() & 63, w = otid() >> 6;
  const int col = lane * 8;
  const float4 g0 = *(const float4*)(dn + (col & 127)), g1 = *(const float4*)(dn + (col & 127) + 4);
  for (int tok = obid() * NWAVE + w; tok < T; tok += gridDim.x * NWAVE) {
    const float4 a0 = *(const float4*)(O1 + (size_t)tok * 512 + col), a1 = *(const float4*)(O1 + (size_t)tok * 512 + col + 4);
    const float4 b0 = *(const float4*)(O2 + (size_t)tok * 512 + col), b1 = *(const float4*)(O2 + (size_t)tok * 512 + col + 4);
    float v[8] = {a0.x - lam * b0.x, a0.y - lam * b0.y, a0.z - lam * b0.z, a0.w - lam * b0.w,
                  a1.x - lam * b1.x, a1.y - lam * b1.y, a1.z - lam * b1.z, a1.w - lam * b1.w};
    float ss = 0.f;
#pragma unroll
    for (int k = 0; k < 8; ++k) ss += v[k] * v[k];
    ss += __shfl_xor(ss, 1);
    ss += __shfl_xor(ss, 2);
    ss += __shfl_xor(ss, 4);
    ss += __shfl_xor(ss, 8);
    const float rstd = rsqrtf(ss * (1.f / 128.f) + EPS) * oml;
    uint4 pk;
    pk.x = pack2(v[0] * rstd * g0.x, v[1] * rstd * g0.y);
    pk.y = pack2(v[2] * rstd * g0.z, v[3] * rstd * g0.w);
    pk.z = pack2(v[4] * rstd * g1.x, v[5] * rstd * g1.y);
    pk.w = pack2(v[6] * rstd * g1.z, v[7] * rstd * g1.w);
    *(uint4*)(mix + (size_t)tok * DM + col) = pk;
  }
}

DI void attnB_item(const Params& P, int S, int item, char* smem) {
  char* ws = opq(P.ws);
  const int nqb = S / 256;
  const int qb = item % nqb, head = (item / nqb) % 6, seq = item / (nqb * 6);
  const int tid = otid(), lane = tid & 63, w = tid >> 6, r = lane & 31, h = lane >> 5;
  const int q0 = seq * S + qb * 256, kv0 = seq * S;
  const u16* QB = (const u16*)(ws + OFF_QB);
  const u16* KB = (const u16*)(ws + OFF_KB);
  const u16* VTB = (const u16*)(ws + OFF_VTB);
  const int tok = q0 + w * 32 + r;
  const float c = 0.07216878364870323f * 1.4426950408889634f;
  f32x16 o[4];
  float lsum;
  attn_pass<192>(QB + (size_t)tok * 1152 + head * 192, KB + (size_t)kv0 * 1152 + head * 192, 1152,
                 VTB + (size_t)(head * 128) * T + kv0, S / 64, c, smem, o, lsum);
  const float il = 1.f / lsum;
  u16* mix = (u16*)(ws + OFF_H);
#pragma unroll
  for (int e = 0; e < 4; ++e)
#pragma unroll
    for (int g = 0; g < 4; ++g) {
      const int e0 = e * 32 + 8 * g + 4 * h;
      uint2 pk;
      pk.x = pack2(o[e][4 * g] * il, o[e][4 * g + 1] * il);
      pk.y = pack2(o[e][4 * g + 2] * il, o[e][4 * g + 3] * il);
      *(uint2*)(mix + (size_t)tok * DM + 512 + head * 128 + e0) = pk;
    }
}

DI void retU_item(const Params& P, int l, int item2) {
  char* ws = opq(P.ws);
  const int tid = otid(), lane = tid & 63, w = (tid >> 6) & 3, r = lane & 31, h = lane >> 5;
  const int item = item2 * 2 + (tid >> 8);
  const int cidx = item / 6, hd = item % 6;
  const float* scal = (const float*)(ws + OFF_SCAL) + l * 32;
  const float lf = scal[2 + hd], lb = scal[8 + hd];
  const u16* VTC = (const u16*)(ws + OFF_VTC);
  const u16* KTC = (const u16*)(ws + OFF_KTC);
  const int t0 = cidx * 128;
  f32x16 af[2], ab[2];
  zero16(af[0]); zero16(af[1]); zero16(ab[0]); zero16(ab[1]);
  const u16* vrow = VTC + (size_t)(hd * 128 + w * 32 + r) * T + t0;
  float gpf[8], gpb[8];
#pragma unroll
  for (int jj = 0; jj < 8; ++jj) { gpf[jj] = fexp2(-lf * (float)jj); gpb[jj] = fexp2(lb * (float)jj); }
#pragma unroll 1
  for (int ks = 0; ks < 8; ++ks) {
    bf16x8 a = ld8(vrow + ks * 16 + h * 8);
    float df[8], db[8];
    const float basef = fexp2(lf * (float)(127 - ks * 16 - h * 8)), baseb = fexp2(lb * (float)(ks * 16 + h * 8));
#pragma unroll
    for (int jj = 0; jj < 8; ++jj) {
      df[jj] = basef * gpf[jj];
      db[jj] = baseb * gpb[jj];
    }
#pragma unroll
    for (int nb = 0; nb < 2; ++nb) {
      uint4 raw = *(const uint4*)(KTC + (size_t)(hd * 64 + nb * 32 + r) * T + t0 + ks * 16 + h * 8);
      float kk[8] = {bflo(raw.x), bfhi(raw.x), bflo(raw.y), bfhi(raw.y), bflo(raw.z), bfhi(raw.z), bflo(raw.w), bfhi(raw.w)};
      uint4 uf, ub;
      uf.x = pack2(kk[0] * df[0], kk[1] * df[1]); uf.y = pack2(kk[2] * df[2], kk[3] * df[3]);
      uf.z = pack2(kk[4] * df[4], kk[5] * df[5]); uf.w = pack2(kk[6] * df[6], kk[7] * df[7]);
      ub.x = pack2(kk[0] * db[0], kk[1] * db[1]); ub.y = pack2(kk[2] * db[2], kk[3] * db[3]);
      ub.z = pack2(kk[4] * db[4], kk[5] * db[5]); ub.w = pack2(kk[6] * db[6], kk[7] * db[7]);
      af[nb] = MFMA32(a, __builtin_bit_cast(bf16x8, uf), af[nb]);
      ab[nb] = MFMA32(a, __builtin_bit_cast(bf16x8, ub), ab[nb]);
    }
  }
  float* U = (float*)(ws + OFF_H) + ((size_t)(cidx * 6 + hd) * 2) * 8192;
#pragma unroll
  for (int nb = 0; nb < 2; ++nb)
#pragma unroll
    for (int i = 0; i < 16; ++i) {
      const int e = w * 32 + crow(i, h), d = nb * 32 + r;
      U[e * 64 + d] = af[nb][i];
      U[8192 + e * 64 + d] = ab[nb][i];
    }
}

DI void phase_ret_scan(const Params& P, int l, int S) {
  char* ws = opq(P.ws);
  const float* scal = (const float*)(ws + OFF_SCAL) + l * 32;
  const float* U = (const float*)(ws + OFF_H);
  u16* R = (u16*)(ws + OFF_R);
  const int nseq = T / S, nc = S / 128;
  const int total = nseq * 6 * 2 * 8192;
  for (int idx = obid() * NTHR + otid(); idx < total; idx += gridDim.x * NTHR) {
    const int el = idx & 8191, dir = (idx >> 13) & 1, hd = (idx >> 14) % 6, seq = idx / (8192 * 12);
    const float gC = fexp2((dir ? scal[8 + hd] : scal[2 + hd]) * 128.f);
    float Rv = 0.f;
    for (int cc0 = 0; cc0 < nc; cc0 += 8) {
      float uv[8];
      size_t oo[8];
#pragma unroll
      for (int k = 0; k < 8; ++k) {
        const int cc = cc0 + k;
        const int ch = dir ? (nc - 1 - cc) : cc;
        oo[k] = ((size_t)((seq * nc + ch) * 6 + hd) * 2 + dir) * 8192 + el;
        uv[k] = U[oo[k]];
      }
#pragma unroll
      for (int k = 0; k < 8; ++k) {
        R[oo[k]] = f2bf(Rv);
        Rv = Rv * gC + uv[k];
      }
    }
  }
}

DI void retOut_item(const Params& P, int l, int item2) {
  char* ws = opq(P.ws);
  const int tid = otid(), lane = tid & 63, w = (tid >> 6) & 3, r = lane & 31, h = lane >> 5;
  const int item = item2 * 2 + (tid >> 8);
  const int cidx = item / 6, hd = item % 6;
  const float* scal = (const float*)(ws + OFF_SCAL) + l * 32;
  const float lf = scal[2 + hd], lb = scal[8 + hd];
  const u16* QC = (const u16*)(ws + OFF_QC);
  const u16* KC = (const u16*)(ws + OFF_KC);
  const u16* VTC = (const u16*)(ws + OFF_VTC);
  const u16* G = (const u16*)(ws + OFF_G);
  const u16* Rf = (const u16*)(ws + OFF_R) + ((size_t)(cidx * 6 + hd) * 2) * 8192;
  const u16* Rb = Rf + 8192;
  const int t0 = cidx * 128, il = w * 32 + r, tok = t0 + il;
  bf16x8 q[4], qf[4], qbk[4];
  const float sf = fexp2(lf * (float)(il + 1)), sb = fexp2(lb * (float)(128 - il));
#pragma unroll
  for (int ks = 0; ks < 4; ++ks) {
    q[ks] = ld8(QC + (size_t)tok * 384 + hd * 64 + ks * 16 + h * 8);
    qf[ks] = scale8(q[ks], sf);
    qbk[ks] = scale8(q[ks], sb);
  }
  f32x16 acc[4];
#pragma unroll
  for (int e = 0; e < 4; ++e) {
    zero16(acc[e]);
#pragma unroll
    for (int ks = 0; ks < 4; ++ks) {
      bf16x8 a = ld8(Rf + (e * 32 + r) * 64 + ks * 16 + h * 8);
      acc[e] = MFMA32(a, qf[ks], acc[e]);
      bf16x8 b = ld8(Rb + (e * 32 + r) * 64 + ks * 16 + h * 8);
      acc[e] = MFMA32(b, qbk[ks], acc[e]);
    }
  }
#pragma unroll 1
  for (int jb = 0; jb < 4; ++jb) {
    f32x16 s;
    zero16(s);
#pragma unroll
    for (int ks = 0; ks < 4; ++ks) {
      bf16x8 a = ld8(KC + (size_t)(t0 + jb * 32 + r) * 384 + hd * 64 + ks * 16 + h * 8);
      s = MFMA32(a, q[ks], s);
    }
#pragma unroll
    for (int i = 0; i < 16; ++i) {
      const int j = jb * 32 + crow(i, h);
      const float d = (float)(il - j);
      const float ex = d >= 0.f ? lf * d : -lb * d;
      s[i] *= fexp2(ex);
    }
#pragma unroll
    for (int s2 = 0; s2 < 2; ++s2) {
      bf16x8 pf = pack8(s, s2);
#pragma unroll
      for (int e = 0; e < 4; ++e) {
        const u16* vp = VTC + (size_t)(hd * 128 + e * 32 + r) * T + t0 + jb * 32 + s2 * 16 + 4 * h;
        uint2 lo = *(const uint2*)vp, hi = *(const uint2*)(vp + 8);
        uint4 u = make_uint4(lo.x, lo.y, hi.x, hi.y);
        acc[e] = MFMA32(__builtin_bit_cast(bf16x8, u), pf, acc[e]);
      }
    }
  }
  float ss = 0.f;
#pragma unroll
  for (int e = 0; e < 4; ++e)
#pragma unroll
    for (int i = 0; i < 16; ++i) ss += acc[e][i] * acc[e][i];
  ss += __shfl_xor(ss, 32);
  const float rstd = rsqrtf(ss * (1.f / 128.f) + EPS);
  const float* rn = P.ret_norm + l * 128;
  u16* mix = (u16*)(ws + OFF_H);
#pragma unroll
  for (int e = 0; e < 4; ++e)
#pragma unroll
    for (int g = 0; g < 4; ++g) {
      const int e0 = e * 32 + 8 * g + 4 * h;
      float4 gn = *(const float4*)(rn + e0);
      uint2 gt = *(const uint2*)(G + (size_t)tok * 768 + hd * 128 + e0);
      uint2 pk;
      pk.x = pack2(acc[e][4 * g] * rstd * gn.x * bflo(gt.x), acc[e][4 * g + 1] * rstd * gn.y * bfhi(gt.x));
      pk.y = pack2(acc[e][4 * g + 2] * rstd * gn.z * bflo(gt.y), acc[e][4 * g + 3] * rstd * gn.w * bfhi(gt.y));
      *(uint2*)(mix + (size_t)tok * DM + 1280 + hd * 128 + e0) = pk;
    }
}

DI uint4 conv8(const uint4& g0, const uint4& g1, const uint4& g2, const uint4& uu, const float (&cb8)[8], const float (&w0)[8],
               const float (&w1)[8], const float (&w2)[8]) {
  uint4 res;
#define CONV2(F, O) { \
    float x0 = cb8[O] + w0[O] * bflo(g0.F) + w1[O] * bflo(g1.F) + w2[O] * bflo(g2.F); \
    float x1 = cb8[O + 1] + w0[O + 1] * bfhi(g0.F) + w1[O + 1] * bfhi(g1.F) + w2[O + 1] * bfhi(g2.F); \
    res.F = pack2(silu(x0) * bflo(uu.F), silu(x1) * bfhi(uu.F)); }
  CONV2(x, 0) CONV2(y, 2) CONV2(z, 4) CONV2(w, 6)
#undef CONV2
  return res;
}

DI void phase_conv(const Params& P, int l, int posmask) {
  char* ws = opq(P.ws);
  const u16* __restrict__ GG = (const u16*)(ws + OFF_GG);
  u16* __restrict__ UU = (u16*)(ws + OFF_UU);
  const float* cw = P.conv_w + (size_t)l * 3 * DFF;
  const float* cbp = P.conv_b + (size_t)l * DFF;
  constexpr int NCG = DFF / 8, TB = 32;
  const int total = (T / TB) * NCG;
  for (int task = obid() * NTHR + otid(); task < total; task += gridDim.x * NTHR) {
    const int tb = task / NCG, c8 = (task % NCG) * 8;
    const int t0 = tb * TB;
    float cb8[8], w0[8], w1[8], w2[8];
#pragma unroll
    for (int k = 0; k < 2; ++k) {
      float4 a = *(const float4*)(cbp + c8 + 4 * k), b0 = *(const float4*)(cw + c8 + 4 * k), b1 = *(const float4*)(cw + DFF + c8 + 4 * k),
             b2 = *(const float4*)(cw + 2 * DFF + c8 + 4 * k);
      cb8[4 * k] = a.x; cb8[4 * k + 1] = a.y; cb8[4 * k + 2] = a.z; cb8[4 * k + 3] = a.w;
      w0[4 * k] = b0.x; w0[4 * k + 1] = b0.y; w0[4 * k + 2] = b0.z; w0[4 * k + 3] = b0.w;
      w1[4 * k] = b1.x; w1[4 * k + 1] = b1.y; w1[4 * k + 2] = b1.z; w1[4 * k + 3] = b1.w;
      w2[4 * k] = b2.x; w2[4 * k + 1] = b2.y; w2[4 * k + 2] = b2.z; w2[4 * k + 3] = b2.w;
    }
    const u16* gp = GG + (size_t)t0 * DFF + c8;
    u16* up = UU + (size_t)t0 * DFF + c8;
    const int s0 = t0 & posmask;
    uint4 gm = *(const uint4*)(gp - (s0 > 0 ? DFF : 0));
    {
      const unsigned k0 = (s0 > 0) ? 0xffffffffu : 0u;
      gm.x &= k0; gm.y &= k0; gm.z &= k0; gm.w &= k0;
    }
    uint4 gc = *(const uint4*)gp;
#pragma unroll 1
    for (int j = 0; j < TB; j += 4) {
      uint4 gn[4], uu[4];
#pragma unroll
      for (int k = 0; k < 4; ++k) {
        const bool last = ((s0 + j + k) == posmask);
        gn[k] = *(const uint4*)(gp + (size_t)(j + k + (last ? 0 : 1)) * DFF);
        const unsigned km = last ? 0u : 0xffffffffu;
        gn[k].x &= km; gn[k].y &= km; gn[k].z &= km; gn[k].w &= km;
        uu[k] = *(const uint4*)(up + (size_t)(j + k) * DFF);
      }
#pragma unroll
      for (int k = 0; k < 4; ++k) {
        const uint4 res = conv8(gm, gc, gn[k], uu[k], cb8, w0, w1, w2);
        *(uint4*)(up + (size_t)(j + k) * DFF) = res;
        gm = gc;
        gc = gn[k];
      }
    }
  }
}

#define XB_TMO      128
#define XB_XCNT(j)  (256  + 64 * (j))
#define XB_XSUB(j)  (1280 + 64 * (j))
#define XB_XGEN(j)  (2304 + 64 * (j))
#define XB_TOP      3328
#define XB_TOPGEN   3392
#define XCD_BAR_WORDS 3456
#define XB_SPIN_CAP (1u << 22)
#define LAS __attribute__((address_space(3)))
DI unsigned xb_ld(unsigned* p) { return __hip_atomic_load(p, __ATOMIC_RELAXED, __HIP_MEMORY_SCOPE_AGENT); }
DI unsigned xb_add(unsigned* p, unsigned v) { return __hip_atomic_fetch_add(p, v, __ATOMIC_RELAXED, __HIP_MEMORY_SCOPE_AGENT); }
DI unsigned xb_xcc_id() { return (unsigned)__builtin_amdgcn_s_getreg((3 << 11) | 20) & 0xFu; }
#define XB_SPIN(cond, bar) do { unsigned _sp = 0; while (cond) { __builtin_amdgcn_s_sleep(1); \
    if ((++_sp & 255u) == 0u) { if (xb_ld(&(bar)[XB_TMO])) break; if (_sp > XB_SPIN_CAP) { atomicAdd(&(bar)[XB_TMO], 1u); break; } } } } while (0)
struct XcdBarrier { unsigned* bar; unsigned x; volatile LAS unsigned* st; };
DI XcdBarrier xcd_barrier_post(unsigned* bar, volatile LAS unsigned* st) {
  XcdBarrier b; b.bar = bar; b.x = xb_xcc_id(); b.st = st;
  if (threadIdx.x == 0) (void)xb_add(&bar[XB_XCNT(b.x)], 1u);
  return b;
}
DI void xcd_barrier_complete(unsigned* bar, unsigned x, unsigned& nloc, unsigned& nx) {
  const unsigned G = gridDim.x * gridDim.y * gridDim.z;
  unsigned sum, cnt, mine, sp = 0u;
  for (;;) {
    sum = 0u; cnt = 0u; mine = 0u;
#pragma unroll
    for (unsigned j = 0; j < 16; ++j) { const unsigned c = xb_ld(&bar[XB_XCNT(j)]); sum += c; cnt += (c > 0u) ? 1u : 0u; mine = (j == x) ? c : mine; }
    if (sum == G) break;
    __builtin_amdgcn_s_sleep(1);
    if ((++sp & 255u) == 0u) { if (xb_ld(&bar[XB_TMO])) break; if (sp > XB_SPIN_CAP) { atomicAdd(&bar[XB_TMO], 1u); break; } }
  }
  nloc = mine > 0u ? mine : 1u; nx = cnt > 0u ? cnt : 1u;
}
template <bool FIRST>
DI void xcd_barrier(const XcdBarrier& b) {
  asm volatile("s_waitcnt vmcnt(0)" ::: "memory");
  __syncthreads();
  if (threadIdx.x == 0) {
    unsigned* bar = b.bar;
    __builtin_amdgcn_s_waitcnt(0);
    unsigned nloc = b.st[0], nx = b.st[1];
    if (FIRST) { xcd_barrier_complete(bar, b.x, nloc, nx); b.st[0] = nloc; b.st[1] = nx; }
    const unsigned old = xb_add(&bar[XB_XSUB(b.x)], 1u);
    const unsigned gen = old / nloc;
    if (old + 1u == (gen + 1u) * nloc) {
      __builtin_amdgcn_fence(__ATOMIC_RELEASE, "agent");
      asm volatile("s_waitcnt vmcnt(0)" ::: "memory");
      const unsigned og = xb_add(&bar[XB_TOP], 1u);
      const unsigned tg = og / nx;
      if (og + 1u == (tg + 1u) * nx) xb_add(&bar[XB_TOPGEN], 1u);
      else XB_SPIN(xb_ld(&bar[XB_TOPGEN]) == tg, bar);
      __builtin_amdgcn_fence(__ATOMIC_ACQUIRE, "agent");
      xb_add(&bar[XB_XGEN(b.x)], 1u);
      asm volatile("s_waitcnt vmcnt(0)" ::: "memory");
    } else {
      XB_SPIN(xb_ld(&bar[XB_XGEN(b.x)]) == gen, bar);
      __builtin_amdgcn_fence(__ATOMIC_ACQUIRE, "agent");
      asm volatile("s_waitcnt vmcnt(0)" ::: "memory");
    }
  }
  __syncthreads();
}

enum { PH_PREP = 0, PH_NORM1, PH_ZGEMM, PH_CQNORM, PH_QKV, PH_SCAN, PH_MIX, PH_COMBINE, PH_WO, PH_NORM2, PH_GU, PH_CONV, PH_DOWN, PH_FINAL, PH_COUNT };

template <int ph>
DI void run_phase(const Params& P, int l, int rq, char* smem, int* s_item, int dup = 0) {
  char* ws = opq(P.ws);
  const int S = rq == 0 ? 16384 : 2048;
  const int posmask = S - 1;
  float* xo = P.out + (size_t)rq * T * DM;
  const float* xcur = (l == 0) ? P.x_in[rq] : xo;
  switch (ph) {
    case PH_PREP:
#if !COOP
      if (l == 0) phase_rope(P);
#endif
      phase_prep(P, l, smem); break;
    case PH_NORM1: phase_rmsnorm_bf16(xcur, P.norm_mix + l * DM, (u16*)(ws + OFF_H)); break;
    case PH_ZGEMM: {
      EpiZ e;
      e.QA = (u16*)(ws + OFF_QA); e.KA = (u16*)(ws + OFF_KA); e.VTA = (u16*)(ws + OFF_VTA); e.CQ = (u16*)(ws + OFF_CQ);
      e.KB = (u16*)(ws + OFF_KB); e.QC = (u16*)(ws + OFF_QC); e.KC = (u16*)(ws + OFF_KC); e.KTC = (u16*)(ws + OFF_KTC);
      e.VTC = (u16*)(ws + OFF_VTC); e.G = (u16*)(ws + OFF_G);
      e.ropeA = (const float2*)(ws + OFF_ROPEA); e.ropeB = (const float2*)(ws + OFF_ROPEB); e.ropeC = (const float2*)(ws + OFF_ROPEC);
      e.posmask = posmask;
      gemm_phase<256, 256>((const u16*)(ws + OFF_H), DM, (const u16*)(ws + OFF_WT_IN), DM, T, INC, DM, smem, e, 0);
    } break;
    case PH_CQNORM: phase_cqnorm((u16*)(ws + OFF_CQ), P.mla_q_norm + l * 512, P.mla_kv_norm + l * 256); break;
    case PH_QKV: {
      EpiUQ e1;
      e1.QB = (u16*)(ws + OFF_QB); e1.ropeB = (const float2*)(ws + OFF_ROPEB); e1.posmask = posmask;
      gemm_phase<256, 256>((const u16*)(ws + OFF_CQ), 768, (const u16*)(ws + OFF_WT_UQ), 512, T, 1152, 512, smem, e1, 0);
      EpiUKV e2;
      e2.KB = (u16*)(ws + OFF_KB); e2.VTB = (u16*)(ws + OFF_VTB);
      const int g = gridDim.x;
      gemm_phase<256, 256>((const u16*)(ws + OFF_CQ) + 512, 768, (const u16*)(ws + OFF_WT_UKV), 256, T, 1536, 256, smem, e2,
                           g - (320 % g));
      const int sh = g - ((320 + 384) % g);
      for (int it = (obid() + sh) % g; it < 64 * 6; it += g) retU_item(P, l, it);
    } break;
    case PH_SCAN: phase_ret_scan(P, l, S); break;
    case PH_MIX: {
      int* cnt = (int*)(ws + OFF_CNT) + (l * 2 + rq) + 4 * dup;
      const int nA = (T / 256) * 8, nB = (T / 256) * 6, nR = 64 * 6;
      for (;;) {
        __syncthreads();
        if (otid() == 0) *s_item = atomicAdd(cnt, 1);
        __syncthreads();
        const int it = *s_item;
        if (it >= nA + nB + nR) break;
        if (it < nB) attnB_item(P, S, it, smem);
        else if (it < nB + nA) attnA_item(P, l, S, it - nB, smem);
        else retOut_item(P, l, it - nB - nA);
      }
    } break;
    case PH_COMBINE: phase_combine(P, l); break;
    case PH_WO: {
      EpiRes e;
      e.xin = xcur; e.out = xo;
      gemm_phase<256, 256>((const u16*)(ws + OFF_H), DM, (const u16*)(ws + OFF_WT_O), DM, T, DM, DM, smem, e, 0);
    } break;
    case PH_NORM2: phase_rmsnorm_bf16(xo, P.norm_ffn + l * DM, (u16*)(ws + OFF_H)); break;
    case PH_GU: {
      EpiGU e;
      e.GG = (u16*)(ws + OFF_GG); e.UU = (u16*)(ws + OFF_UU);
      gemm_phase<256, 256>((const u16*)(ws + OFF_H), DM, (const u16*)(ws + OFF_WT_GU), DM, T, 2 * DFF, DM, smem, e, 0);
    } break;
    case PH_CONV: phase_conv(P, l, posmask); break;
    case PH_DOWN: {
      EpiRes e;
      e.xin = xo; e.out = xo;
      gemm_phase<256, 256>((const u16*)(ws + OFF_UU), DFF, (const u16*)(ws + OFF_WT_DN), DFF, T, DM, DFF, smem, e, 0);
    } break;
    case PH_FINAL: phase_final_norm(xo, P.norm_final); break;
  }
}

#if COOP
__global__ void __launch_bounds__(NTHR, 2) mega_kernel(Params P) {
  extern __shared__ __attribute__((aligned(16))) char smem[];
  int* s_itemp = (int*)(smem + LDS_MAIN);
  uint4* xbw = (uint4*)(smem + LDS_MAIN + 16);
  cg::grid_group grid = cg::this_grid();
  if (threadIdx.x == 0) *xbw = make_uint4(0u, 0u, 0u, 0u);
  __syncthreads();
  XcdBarrier xb = xcd_barrier_post((unsigned*)(P.ws + OFF_BAR), (volatile LAS unsigned*)xbw);
#define GSYNC() xcd_barrier<false>(xb)
  phase_rope(P);
#pragma unroll 1
  for (int l = 0; l < 2; ++l) {
    run_phase<PH_PREP>(P, l, 0, smem, s_itemp);
    if (l == 0) { grid.sync(); xcd_barrier<true>(xb); } else GSYNC();
#pragma unroll 1
    for (int rq = 0; rq < 2; ++rq) {
      run_phase<PH_NORM1>(P, l, rq, smem, s_itemp);  GSYNC();
      run_phase<PH_ZGEMM>(P, l, rq, smem, s_itemp);  GSYNC();
      run_phase<PH_CQNORM>(P, l, rq, smem, s_itemp); GSYNC();
      run_phase<PH_QKV>(P, l, rq, smem, s_itemp);    GSYNC();
      run_phase<PH_SCAN>(P, l, rq, smem, s_itemp);   GSYNC();
      run_phase<PH_MIX>(P, l, rq, smem, s_itemp);    GSYNC();
      run_phase<PH_COMBINE>(P, l, rq, smem, s_itemp); GSYNC();
      run_phase<PH_WO>(P, l, rq, smem, s_itemp);     GSYNC();
      run_phase<PH_NORM2>(P, l, rq, smem, s_itemp);  GSYNC();
      run_phase<PH_GU>(P, l, rq, smem, s_itemp);     GSYNC();
      run_phase<PH_CONV>(P, l, rq, smem, s_itemp);   GSYNC();
      run_phase<PH_DOWN>(P, l, rq, smem, s_itemp);   GSYNC();
    }
  }
  run_phase<PH_FINAL>(P, 0, 0, smem, s_itemp);
  run_phase<PH_FINAL>(P, 0, 1, smem, s_itemp);
}
#else
template <int PH>
__global__ void __launch_bounds__(NTHR, 2) phase_kernel(Params P, int l, int rq) {
  extern __shared__ __attribute__((aligned(16))) char smem[];
  int* s_itemp = (int*)(smem + LDS_MAIN);
  run_phase<PH>(P, l, rq, smem, s_itemp);
}
#endif

extern "C" void kernel_launch(void* const* d_in, const int* in_sizes, int n_in, void* d_out, int out_size, void* d_ws,
                              size_t ws_size, hipStream_t stream) {
  Params P{};
  P.x_in[0] = (const float*)d_in[0];
  P.x_in[1] = (const float*)d_in[1];
  P.norm_mix = (const float*)d_in[2];
  P.w_in = (const float*)d_in[3];
  P.diff_lambda = (const float*)d_in[4];
  P.diff_norm = (const float*)d_in[5];
  P.mla_q_norm = (const float*)d_in[6];
  P.mla_kv_norm = (const float*)d_in[7];
  P.w_uq = (const float*)d_in[8];
  P.w_ukv = (const float*)d_in[9];
  P.ret_decay_fwd = (const float*)d_in[10];
  P.ret_decay_bwd = (const float*)d_in[11];
  P.ret_norm = (const float*)d_in[12];
  P.w_o = (const float*)d_in[13];
  P.norm_ffn = (const float*)d_in[14];
  P.w_gate = (const float*)d_in[15];
  P.w_up = (const float*)d_in[16];
  P.conv_w = (const float*)d_in[17];
  P.conv_b = (const float*)d_in[18];
  P.w_down = (const float*)d_in[19];
  P.norm_final = (const float*)d_in[20];
  P.out = (float*)d_out;
  P.ws = (char*)d_ws;
  if (ws_size < OFF_FFNEND || ws_size < OFF_MIXEND) {
    fprintf(stderr, "workspace too small: %zu\n", ws_size);
    return;
  }
  (void)hipMemsetAsync((char*)d_ws + OFF_CNT, 0, 4096 + 16384, stream);
#if COOP
  static int grid_blocks = 0;
  if (!grid_blocks) {
    int dev = 0, cus = 0, per_cu = 0;
    (void)hipGetDevice(&dev);
    (void)hipDeviceGetAttribute(&cus, hipDeviceAttributeMultiprocessorCount, dev);
    (void)hipFuncSetAttribute((const void*)mega_kernel, hipFuncAttributeMaxDynamicSharedMemorySize, DYN_LDS);
    (void)hipOccupancyMaxActiveBlocksPerMultiprocessor(&per_cu, mega_kernel, NTHR, DYN_LDS);
    if (per_cu > 1) per_cu = 1;
    if (per_cu < 1) per_cu = 1;
    grid_blocks = cus * per_cu;
  }
  void* args[] = {&P};
  hipError_t e = hipLaunchCooperativeKernel((const void*)mega_kernel, dim3(grid_blocks), dim3(NTHR), args, DYN_LDS, stream);
  if (e != hipSuccess) fprintf(stderr, "cooperative launch failed: %s (grid %d)\n", hipGetErrorString(e), grid_blocks);
#else
  const int grid = 256;
#define LP(PH, l, rq) do { (void)hipFuncSetAttribute((const void*)phase_kernel<PH>, hipFuncAttributeMaxDynamicSharedMemorySize, DYN_LDS); phase_kernel<PH><<<grid, NTHR, DYN_LDS, stream>>>(P, l, rq); } while (0)
  for (int l = 0; l < 2; ++l) {
    LP(PH_PREP, l, 0);
    for (int rq = 0; rq < 2; ++rq) {
      LP(PH_NORM1, l, rq); LP(PH_ZGEMM, l, rq); LP(PH_CQNORM, l, rq); LP(PH_QKV, l, rq); LP(PH_SCAN, l, rq); LP(PH_MIX, l, rq); LP(PH_COMBINE, l, rq);
      LP(PH_WO, l, rq); LP(PH_NORM2, l, rq); LP(PH_GU, l, rq); LP(PH_CONV, l, rq); LP(PH_DOWN, l, rq);
    }
  }
  LP(PH_FINAL, 0, 0);
  LP(PH_FINAL, 0, 1);
#endif
}
```
